# Optimizing an MI355X kernel written in HIP

```python
import jax, jax.numpy as jnp
from jax import lax
import numpy as np

D_MODEL = 2048
BATCH = 1
SEQ = 8192
DEPTH = 4

N_A_LAYERS = DEPTH // 2
N_B_LAYERS = DEPTH - N_A_LAYERS
EPS = 1e-6
MOD_INIT = 0.1
N_MOD = 6

CHUNK = 128
SGU_WIDTH = 2 * D_MODEL
SGU_GROUPS = 16
SGU_GROUP_DIM = SGU_WIDTH // SGU_GROUPS

D_FF = 11 * D_MODEL // 4
CONV_W = 3

N_HEADS = 16
HEAD_DIM = D_MODEL // N_HEADS
N_KV = 4
GROUP = N_HEADS // N_KV
N_BRANCH = 3
N_KV_TENSORS = 2 * N_BRANCH
CMP_LEN = 32
CMP_STRIDE = 16
SLC_LEN = 64
SLC_TOPK = 16
N_FORCED_LOCAL = 2
WINDOW = 512
Q_BLOCK = 128
NEG_INF = -1e30
FORCE_BONUS = 1e4

kernel_name = 'yoco_sgu_nsa_hybrid'


def alibi_slopes():
    h = jnp.arange(1, N_HEADS + 1, dtype=jnp.float32)
    return (2.0 ** (-8.0 * h / N_HEADS)).reshape(N_KV, GROUP)


def rms_norm(x, gain):
    xf = x.astype(jnp.float32)
    y = xf * lax.rsqrt(jnp.mean(xf * xf, axis=-1, keepdims=True) + EPS)
    return (y * gain.astype(jnp.float32)).astype(x.dtype)


def adaln(c, w, b, n):
    m = jax.nn.silu(c) @ w + b
    return jnp.split(m[:, None, :], n, axis=-1)


def modulate(x, gain, shift, scale):
    return rms_norm(x, gain) * (1 + scale) + shift


def masked_softmax(s, valid):
    s = jnp.where(valid, s, NEG_INF)
    m = jnp.max(s, axis=-1, keepdims=True)
    e = jnp.where(valid, jnp.exp(s - m), 0.0)
    return e / jnp.maximum(jnp.sum(e, axis=-1, keepdims=True), 1e-30)


def conv_ffn(h, w_up, conv_w, conv_b, w_down):
    T = h.shape[1]
    z = h @ w_up
    zp = jnp.pad(z, ((0, 0), (CONV_W - 1, 0), (0, 0)))
    z = conv_b + sum(conv_w[k] * zp[:, k:k + T] for k in range(CONV_W))
    a, v = jnp.split(z, 2, axis=-1)
    return (jax.nn.silu(a) * v) @ w_down


def chunked_sgu(h, w_in, v_gain, w_s, b_s, w_out):
    B, T, _ = h.shape
    u, v = jnp.split(jax.nn.gelu(h @ w_in), 2, axis=-1)
    v = rms_norm(v, v_gain).reshape(B, T // CHUNK, CHUNK, SGU_GROUPS, SGU_GROUP_DIM)
    w_causal = jnp.where(jnp.tril(jnp.ones((CHUNK, CHUNK), dtype=bool)), w_s, 0.0)
    sv = jnp.einsum('gts,bnsgc->bntgc', w_causal, v) + b_s.T[:, :, None]
    return (u * sv.reshape(B, T, SGU_WIDTH)) @ w_out


def nsa_shared_kv(x, c, gain, mod_w, mod_b, w_kv, cmp_pos, cmp_w1, cmp_w2, k_gain):
    B, T, _ = x.shape
    shift, scale = adaln(c, mod_w, mod_b, 2)
    h = modulate(x, gain, shift, scale)
    kv = (h @ w_kv).reshape(B, T, N_KV_TENSORS, N_KV, HEAD_DIM)
    n_cmp = T // CMP_STRIDE - 1

    def compress(t, i):
        s = t.reshape(B, T // CMP_STRIDE, CMP_STRIDE, N_KV, HEAD_DIM)
        blocks = jnp.concatenate([s[:, :-1], s[:, 1:]], axis=2) + cmp_pos[i][:, None, :]
        flat = blocks.transpose(0, 1, 3, 2, 4).reshape(B, n_cmp, N_KV, CMP_LEN * HEAD_DIM)
        return jax.nn.gelu(flat @ cmp_w1[i]) @ cmp_w2[i]

    k_cmp = rms_norm(compress(kv[:, :, 0], 0), k_gain[0])
    v_cmp = compress(kv[:, :, 1], 1)
    k_slc = rms_norm(kv[:, :, 2], k_gain[1])
    v_slc = kv[:, :, 3]
    k_win = rms_norm(kv[:, :, 4], k_gain[2])
    v_win = kv[:, :, 5]
    return (k_cmp, v_cmp, k_slc, v_slc, k_win, v_win)


def nsa_attention(h, kv, w_in, q_gain, w_o):
    k_cmp, v_cmp, k_slc, v_slc, k_win, v_win = kv
    B, T, _ = h.shape
    f32 = jnp.float32
    proj = h @ w_in
    q = rms_norm(proj[..., :N_HEADS * HEAD_DIM].reshape(B, T, N_KV, GROUP, HEAD_DIM), q_gain)
    gates = jax.nn.sigmoid(proj[..., N_HEADS * HEAD_DIM:].astype(f32)).reshape(B, T, N_BRANCH, N_KV, GROUP)
    sl = alibi_slopes()[None, :, :, None, None]
    scale = HEAD_DIM ** -0.5
    n_cmp = k_cmp.shape[1]
    n_slc = T // SLC_LEN
    top_k = min(SLC_TOPK, n_slc)
    cmp_start = jnp.arange(n_cmp) * CMP_STRIDE
    cmp_end = cmp_start + CMP_LEN - 1
    blk = jnp.arange(n_slc)
    slc_start = blk * SLC_LEN
    overlap = ((cmp_start[:, None] < slc_start[None, :] + SLC_LEN)
               & (cmp_start[:, None] + CMP_LEN > slc_start[None, :])).astype(f32)
    k_blocks = k_slc.reshape(B, n_slc, SLC_LEN, N_KV, HEAD_DIM).transpose(0, 3, 1, 2, 4)
    v_blocks = v_slc.reshape(B, n_slc, SLC_LEN, N_KV, HEAD_DIM).transpose(0, 3, 1, 2, 4)
    k_win_p = jnp.pad(k_win, ((0, 0), (WINDOW, 0), (0, 0), (0, 0)))
    v_win_p = jnp.pad(v_win, ((0, 0), (WINDOW, 0), (0, 0), (0, 0)))
    b_ix = jnp.arange(B)[:, None, None, None]
    g_ix = jnp.arange(N_KV)[None, :, None, None]
    tok = jnp.arange(SLC_LEN)
    n_sel = top_k * SLC_LEN

    def query_block(qb):
        t0 = qb * Q_BLOCK
        qi = lax.dynamic_slice_in_dim(q, t0, Q_BLOCK, axis=1)
        gi = lax.dynamic_slice_in_dim(gates, t0, Q_BLOCK, axis=1)
        t = t0 + jnp.arange(Q_BLOCK)
        d_cmp = t[:, None] - cmp_end[None, :]
        s = jnp.einsum('bqgrd,bngd->bgrqn', qi, k_cmp, preferred_element_type=f32) * scale - sl * d_cmp
        p_cmp = masked_softmax(s, d_cmp >= 0)
        o_cmp = jnp.einsum('bgrqn,bngd->bqgrd', p_cmp, v_cmp.astype(f32))
        imp = jnp.einsum('bgrqn,ns->bgqs', p_cmp, overlap)
        cur = (t // SLC_LEN)[:, None]
        forced = (blk[None, :] == 0) | ((blk[None, :] <= cur) & (blk[None, :] > cur - N_FORCED_LOCAL))
        imp = jnp.where(forced, imp + FORCE_BONUS, imp)
        imp = jnp.where(blk[None, :] <= cur, imp, NEG_INF)
        _, idx = lax.top_k(imp, top_k)
        ks = k_blocks[b_ix, g_ix, idx].reshape(B, N_KV, Q_BLOCK, n_sel, HEAD_DIM)
        vs = v_blocks[b_ix, g_ix, idx].reshape(B, N_KV, Q_BLOCK, n_sel, HEAD_DIM)
        d_slc = (t[None, None, :, None, None] - (idx[..., None] * SLC_LEN + tok)).reshape(B, N_KV, 1, Q_BLOCK, n_sel)
        s = jnp.einsum('bqgrd,bgqkd->bgrqk', qi, ks, preferred_element_type=f32) * scale - sl * d_slc
        p = masked_softmax(s, d_slc >= 0)
        o_slc = jnp.einsum('bgrqk,bgqkd->bqgrd', p, vs.astype(f32))
        kw = lax.dynamic_slice_in_dim(k_win_p, t0, Q_BLOCK + WINDOW, axis=1)
        vw = lax.dynamic_slice_in_dim(v_win_p, t0, Q_BLOCK + WINDOW, axis=1)
        sp = t0 - WINDOW + jnp.arange(Q_BLOCK + WINDOW)
        d_win = t[:, None] - sp[None, :]
        valid = (d_win >= 0) & (d_win < WINDOW) & (sp[None, :] >= 0)
        s = jnp.einsum('bqgrd,bkgd->bgrqk', qi, kw, preferred_element_type=f32) * scale - sl * d_win
        p = masked_softmax(s, valid)
        o_win = jnp.einsum('bgrqk,bkgd->bqgrd', p, vw.astype(f32))
        g = gi[..., None]
        return g[:, :, 0] * o_cmp + g[:, :, 1] * o_slc + g[:, :, 2] * o_win

    out = lax.map(query_block, jnp.arange(T // Q_BLOCK))
    out = out.transpose(1, 0, 2, 3, 4, 5).reshape(B, T, N_HEADS * HEAD_DIM).astype(h.dtype)
    return out @ w_o


def setup_inputs(seed: int = 0) -> dict:
    key = jax.random.key(seed)
    ks = jax.random.split(key, 32)
    f32 = jnp.float32

    def dense(k, shape, fan_in, mult=1.0):
        return jax.random.normal(k, shape, f32) * (mult * fan_in ** -0.5)

    def near_one(k, shape):
        return 1.0 + 0.02 * jax.random.normal(k, shape, f32)

    def small(k, shape):
        return 0.02 * jax.random.normal(k, shape, f32)

    gate_offset = jnp.zeros((N_MOD, D_MODEL), f32).at[jnp.array([2, 5])].set(1.0).reshape(N_MOD * D_MODEL)
    return {
        'x': jax.random.normal(ks[0], (BATCH, SEQ, D_MODEL), f32),
        'c': jax.random.normal(ks[1], (BATCH, D_MODEL), f32),
        'mod_w': dense(ks[2], (DEPTH, D_MODEL, N_MOD * D_MODEL), D_MODEL, MOD_INIT),
        'mod_b': small(ks[3], (DEPTH, N_MOD * D_MODEL)) + gate_offset,
        'norm_gain': near_one(ks[4], (DEPTH, 2, D_MODEL)),
        'ffn_w_up': dense(ks[5], (DEPTH, D_MODEL, 2 * D_FF), D_MODEL),
        'ffn_conv_w': dense(ks[6], (DEPTH, CONV_W, 2 * D_FF), CONV_W),
        'ffn_conv_b': small(ks[7], (DEPTH, 2 * D_FF)),
        'ffn_w_down': dense(ks[8], (DEPTH, D_FF, D_MODEL), D_FF),
        'sgu_w_in': dense(ks[9], (N_A_LAYERS, D_MODEL, 2 * SGU_WIDTH), D_MODEL),
        'sgu_v_gain': near_one(ks[10], (N_A_LAYERS, SGU_WIDTH)),
        'sgu_w_s': dense(ks[11], (N_A_LAYERS, SGU_GROUPS, CHUNK, CHUNK), CHUNK),
        'sgu_b_s': near_one(ks[12], (N_A_LAYERS, SGU_GROUPS, CHUNK)),
        'sgu_w_out': dense(ks[13], (N_A_LAYERS, SGU_WIDTH, D_MODEL), SGU_WIDTH),
        'kv_gain': near_one(ks[14], (D_MODEL,)),
        'kv_mod_w': dense(ks[15], (D_MODEL, 2 * D_MODEL), D_MODEL, MOD_INIT),
        'kv_mod_b': small(ks[16], (2 * D_MODEL,)),
        'w_kv': dense(ks[17], (D_MODEL, N_KV_TENSORS * N_KV * HEAD_DIM), D_MODEL),
        'cmp_pos': 0.5 * jax.random.normal(ks[18], (2, CMP_LEN, HEAD_DIM), f32),
        'cmp_w1': dense(ks[19], (2, CMP_LEN * HEAD_DIM, HEAD_DIM), CMP_LEN * HEAD_DIM),
        'cmp_w2': dense(ks[20], (2, HEAD_DIM, HEAD_DIM), HEAD_DIM),
        'k_gain': near_one(ks[21], (N_BRANCH, HEAD_DIM)),
        'nsa_w_in': dense(ks[22], (N_B_LAYERS, D_MODEL, N_HEADS * HEAD_DIM + N_BRANCH * N_HEADS), D_MODEL),
        'nsa_q_gain': near_one(ks[23], (N_B_LAYERS, HEAD_DIM)),
        'nsa_w_o': dense(ks[24], (N_B_LAYERS, N_HEADS * HEAD_DIM, D_MODEL), N_HEADS * HEAD_DIM),
    }


def reference(x, c, mod_w, mod_b, norm_gain, ffn_w_up, ffn_conv_w, ffn_conv_b, ffn_w_down,
              sgu_w_in, sgu_v_gain, sgu_w_s, sgu_b_s, sgu_w_out,
              kv_gain, kv_mod_w, kv_mod_b, w_kv, cmp_pos, cmp_w1, cmp_w2, k_gain,
              nsa_w_in, nsa_q_gain, nsa_w_o):
    shared_kv = None
    for layer in range(DEPTH):
        if layer == N_A_LAYERS:
            shared_kv = nsa_shared_kv(x, c, kv_gain, kv_mod_w, kv_mod_b, w_kv, cmp_pos, cmp_w1, cmp_w2, k_gain)
        sh1, sc1, g1, sh2, sc2, g2 = adaln(c, mod_w[layer], mod_b[layer], N_MOD)
        h = modulate(x, norm_gain[layer, 0], sh1, sc1)
        if layer < N_A_LAYERS:
            a = layer
            y = chunked_sgu(h, sgu_w_in[a], sgu_v_gain[a], sgu_w_s[a], sgu_b_s[a], sgu_w_out[a])
        else:
            bl = layer - N_A_LAYERS
            y = nsa_attention(h, shared_kv, nsa_w_in[bl], nsa_q_gain[bl], nsa_w_o[bl])
        x = x + g1 * y
        h = modulate(x, norm_gain[layer, 1], sh2, sc2)
        x = x + g2 * conv_ffn(h, ffn_w_up[layer], ffn_conv_w[layer], ffn_conv_b[layer], ffn_w_down[layer])
    return x
```

```cpp
#include <hip/hip_runtime.h>
#include <cstdio>
#include <cstdint>
namespace pg8 {
#define PG8_LAS __attribute__((address_space(3)))
typedef unsigned short bf16_t;
typedef short bf16x8 __attribute__((ext_vector_type(8)));
typedef float f32x4 __attribute__((ext_vector_type(4)));
typedef unsigned u32x4 __attribute__((ext_vector_type(4)));
constexpr int BM = 256, BK = 64, HALF = 128, HTB = HALF * BK * 2  , STAGE_BYTES = 8 * HTB, NXCD = 8, WGM = 8;

__host__ __device__ __forceinline__ int lds_byte(int r, int c) { const int st = (r >> 4) * 2 + (c >> 5), rr = r & 15, cc = c & 31, ob = rr * 64 + cc * 2; return st * 1024 + (ob ^ (((ob >> 9) & 1) << 5)); }
__host__ __device__ __forceinline__ void stage_rc(int b, int& R, int& C) { const int st = b / 1024, sb = b % 1024, swz = sb ^ (((sb >> 9) & 1) << 5); R = (st >> 1) * 16 + swz / 64; C = (st & 1) * 32 + (swz % 64) / 2; }
__host__ __device__ __forceinline__ int perm32(int rho) { const int n = rho >> 4, i = rho & 15; return 8 * (i >> 2) + 4 * n + (i & 3); }

struct Unit { int pm, pn; };
struct Gemm { const bf16_t* A; const bf16_t* Bt; int M, N, K; };

struct StaticOrder {
    int nM, nN, nwg, G, c;
    __host__ __device__ void init(int M, int N, int G_, int c_) { nM = M / BM; nN = N / BM; nwg = nM * nN; G = G_; c = c_; }
    __host__ __device__ bool next(int i, Unit& u) const {
        const long L = (long)i * G + c; if (L >= nwg) return false;
        int wgid = (int)L; { const int q = nwg / NXCD, r = nwg % NXCD, xcd = wgid % NXCD, off = wgid / NXCD; wgid = (xcd < r ? xcd * (q + 1) : r * (q + 1) + (xcd - r) * q) + off; }
        const int nig = WGM * nN, gid = wgid / nig, fm = gid * WGM, gsz = (nM - fm) < WGM ? (nM - fm) : WGM;
        u.pm = fm + ((wgid % nig) % gsz); u.pn = (wgid % nig) / gsz; return true;
    }
    __device__ __forceinline__ void a_ready(const Unit&) const {}
    __device__ __forceinline__ void done(const Unit&) const {}
};


__device__ __forceinline__ unsigned cvt_pk_bf16(float lo, float hi) { unsigned r; asm volatile("v_cvt_pk_bf16_f32 %0, %1, %2" : "=v"(r) : "v"(lo), "v"(hi)); return r; }
__device__ __forceinline__ float gelu_tanh(float v) {
    const float inner = v * (1.0f + 0.044715f * v * v);
    const float e = __builtin_amdgcn_exp2f(-2.3022081997f * inner);
    return v * __builtin_amdgcn_rcpf(1.0f + e);
}
template <int ACT  > struct EpiBf16 {
    static constexpr bool PERM = true, AFTER_DRAIN = false;
    bf16_t* O; int ldc;
    __device__ __forceinline__ void operator()(const f32x4 (&acc)[2][2][4][2], const Unit& u, int wr, int wc, int fr, int fq) const {
        const int row0 = u.pm * BM + wr * 64 + fr; const int col0 = u.pn * BM + wc * 32 + 8 * fq;
#pragma unroll
        for (int ai = 0; ai < 2; ++ai)
#pragma unroll
            for (int m = 0; m < 4; ++m) { bf16_t* rowp = O + (size_t)(row0 + ai * HALF + m * 16) * ldc + col0;
#pragma unroll
                for (int bj = 0; bj < 2; ++bj) { f32x4 v0 = acc[ai][bj][m][0], v1 = acc[ai][bj][m][1];
                    if (ACT == 1) {
#pragma unroll
                        for (int j = 0; j < 4; ++j) { v0[j] = gelu_tanh(v0[j]); v1[j] = gelu_tanh(v1[j]); } }
                    u32x4 w; w.x = cvt_pk_bf16(v0[0], v0[1]); w.y = cvt_pk_bf16(v0[2], v0[3]); w.z = cvt_pk_bf16(v1[0], v1[1]); w.w = cvt_pk_bf16(v1[2], v1[3]);
                    *(u32x4*)(rowp + bj * HALF) = w; } }
    }
};
struct EpiResid {
    static constexpr bool PERM = false, AFTER_DRAIN = false;
    const float* base; float* out; int ldc; const float* gate;
    __device__ __forceinline__ void operator()(const f32x4 (&acc)[2][2][4][2], const Unit& u, int wr, int wc, int fr, int fq) const {
        const int row0 = u.pm * BM + wr * 64 + fr, col0 = u.pn * BM + wc * 32 + 4 * fq;
        f32x4 gv[2][2];
#pragma unroll
        for (int bj = 0; bj < 2; ++bj)
#pragma unroll
            for (int n = 0; n < 2; ++n) gv[bj][n] = *(const f32x4*)(gate + col0 + bj * HALF + n * 16);
#pragma unroll
        for (int ai = 0; ai < 2; ++ai)
#pragma unroll
            for (int m = 0; m < 4; ++m) { const size_t off = (size_t)(row0 + ai * HALF + m * 16) * ldc + col0;
#pragma unroll
                for (int bj = 0; bj < 2; ++bj)
#pragma unroll
                    for (int n = 0; n < 2; ++n) { const f32x4 bs = *(const f32x4*)(base + off + bj * HALF + n * 16);
                        *(f32x4*)(out + off + bj * HALF + n * 16) = bs + gv[bj][n] * acc[ai][bj][m][n]; } }
    }
};
template <class Epi, class Sched, bool ALIGN_EPI = false, bool SP2 = false>
__device__ __forceinline__ void gemm_phase(PG8_LAS unsigned char* lds, const Gemm g, const Sched& S, const Epi& E, const int tid) {
    const int wid = __builtin_amdgcn_readfirstlane(tid >> 6), lane = tid & 63, wr = wid >> 2, wc = wid & 3, fr = lane & 15, fq = lane >> 4;
    const int K = g.K, nt = K / BK;
    unsigned voffA[2], voffB[2];
#pragma unroll
    for (int i = 0; i < 2; ++i) { int R, C; stage_rc(tid * 16 + i * 8192, R, C); const int Rb = Epi::PERM ? ((R & ~31) + perm32(R & 31)) : R;
        voffA[i] = (unsigned)(R * K + C) * 2u; voffB[i] = (unsigned)(Rb * K + C) * 2u; }
    const size_t kstep = (size_t)(BK * 2);
    const size_t hstep = (size_t)HALF * K * 2;
    const size_t tstep = 2 * hstep;
    const unsigned ldsw = (unsigned)wid * 1024u;
    const int aoff = lds_byte(wr * 64 + fr, fq * 8), boff = lds_byte(wc * 32 + fr, fq * 8);
#define PG8_SA(b, h) (((b) * 2 + (h)) * HTB)
#define PG8_SB(b, h) ((4 + (b) * 2 + (h)) * HTB)
#define PG8_STAGE(bufoff, gbase, voff) do { _Pragma("unroll") for (int _i = 0; _i < 2; ++_i) \
        __builtin_amdgcn_global_load_lds((const unsigned*)((const char*)(gbase) + (voff)[_i]), (PG8_LAS unsigned*)(lds + (bufoff) + ldsw + _i * 8192), 16, 0, 0); } while (0)
#define PG8_LDA(dst, b, h) do { _Pragma("unroll") for (int m = 0; m < 4; ++m) _Pragma("unroll") for (int k = 0; k < 2; ++k) dst[m][k] = *(const PG8_LAS bf16x8*)(lds + PG8_SA(b, h) + aoff + m * 2048 + k * 1024); } while (0)
#define PG8_LDB(dst, b, h) do { _Pragma("unroll") for (int n = 0; n < 2; ++n) _Pragma("unroll") for (int k = 0; k < 2; ++k) dst[n][k] = *(const PG8_LAS bf16x8*)(lds + PG8_SB(b, h) + boff + n * 2048 + k * 1024); } while (0)
#define PG8_MMA(ai, bj, At, Bt) do { __builtin_amdgcn_s_setprio(1); _Pragma("unroll") for (int m = 0; m < 4; ++m) _Pragma("unroll") for (int n = 0; n < 2; ++n) _Pragma("unroll") for (int k = 0; k < 2; ++k) \
        acc[ai][bj][m][n] = __builtin_amdgcn_mfma_f32_16x16x32_bf16(Bt[n][k], At[m][k], acc[ai][bj][m][n], 0, 0, 0); __builtin_amdgcn_s_setprio(0); } while (0)
#define PG8_WAIT_V(n) asm volatile("s_waitcnt vmcnt(" #n ")" ::: "memory")
#define PG8_WAIT_L(n) asm volatile("s_waitcnt lgkmcnt(" #n ")" ::: "memory")
#define PG8_BAR __builtin_amdgcn_s_barrier()
#define PG8_SCHED __builtin_amdgcn_sched_barrier(0)
    Unit cur, nxt; int ui = 0;
    if (!S.next(0, cur)) return;
    f32x4 acc[2][2][4][2];
#pragma unroll
    for (int a = 0; a < 2; ++a)
#pragma unroll
        for (int b = 0; b < 2; ++b)
#pragma unroll
            for (int m = 0; m < 4; ++m)
#pragma unroll
                for (int n = 0; n < 2; ++n) acc[a][b][m][n] = (f32x4){0.f, 0.f, 0.f, 0.f};
    bf16x8 At[4][2], B0[2][2], B1[2][2];
    const char* cA = (const char*)g.A + (size_t)cur.pm * tstep; const char* cB = (const char*)g.Bt + (size_t)cur.pn * tstep;
    S.a_ready(cur);
    if constexpr (SP2) {
        PG8_STAGE(PG8_SB(0, 0), cB, voffB); PG8_STAGE(PG8_SB(0, 1), cB + hstep, voffB); PG8_STAGE(PG8_SA(0, 0), cA, voffA); PG8_STAGE(PG8_SA(0, 1), cA + hstep, voffA);
        if (wr == 1) PG8_BAR;
        PG8_WAIT_V(2); PG8_BAR;
        PG8_STAGE(PG8_SB(1, 0), cB + kstep, voffB); PG8_STAGE(PG8_SA(1, 0), cA + kstep, voffA); PG8_STAGE(PG8_SB(1, 1), cB + hstep + kstep, voffB);
        PG8_WAIT_V(6); PG8_BAR;
    } else {
        PG8_STAGE(PG8_SB(0, 0), cB, voffB); PG8_STAGE(PG8_SA(0, 0), cA, voffA); PG8_STAGE(PG8_SB(0, 1), cB + hstep, voffB); PG8_STAGE(PG8_SA(0, 1), cA + hstep, voffA);
        if (wr == 1) PG8_BAR;
        PG8_WAIT_V(4); PG8_BAR;
        PG8_STAGE(PG8_SB(1, 0), cB + kstep, voffB); PG8_STAGE(PG8_SA(1, 0), cA + kstep, voffA); PG8_STAGE(PG8_SB(1, 1), cB + hstep + kstep, voffB);
        PG8_WAIT_V(6); PG8_BAR;
    }
    for (;;) {
        const bool has_next = S.next(ui + 1, nxt);
        const char* nA = has_next ? (const char*)g.A + (size_t)nxt.pm * tstep : cA; const char* nB = has_next ? (const char*)g.Bt + (size_t)nxt.pn * tstep : cB;
        for (int t = 0; t < nt; t += 2) {
            const bool last = (t == nt - 2);
            const char* a1 = cA + (size_t)(t + 1) * kstep;
            const char* a2 = last ? nA : cA + (size_t)(t + 2) * kstep; const char* b2 = last ? nB : cB + (size_t)(t + 2) * kstep;
            const char* a3 = a2 + kstep; const char* b3 = b2 + kstep;
            if (last && has_next) S.a_ready(nxt);
            if constexpr (SP2) {
            PG8_LDB(B0, 0, 0); PG8_LDB(B1, 0, 1); PG8_SCHED; PG8_LDA(At, 0, 0); PG8_STAGE(PG8_SA(1, 1), a1 + hstep, voffA);
            PG8_WAIT_V(8); PG8_WAIT_L(0); PG8_BAR; PG8_MMA(0, 0, At, B0); PG8_MMA(0, 1, At, B1); PG8_BAR; PG8_SCHED;
            PG8_LDA(At, 0, 1); PG8_STAGE(PG8_SB(0, 0), b2, voffB); PG8_STAGE(PG8_SB(0, 1), b2 + hstep, voffB); PG8_STAGE(PG8_SA(0, 0), a2, voffA);
            PG8_WAIT_V(8); PG8_WAIT_L(0); PG8_BAR; PG8_MMA(1, 0, At, B0); PG8_MMA(1, 1, At, B1); PG8_BAR; PG8_SCHED;
            PG8_LDB(B0, 1, 0); PG8_LDB(B1, 1, 1); PG8_SCHED; PG8_LDA(At, 1, 0); PG8_STAGE(PG8_SA(0, 1), a2 + hstep, voffA);
            PG8_WAIT_V(8); PG8_WAIT_L(0); PG8_BAR; PG8_MMA(0, 0, At, B0); PG8_MMA(0, 1, At, B1); PG8_BAR; PG8_SCHED;
            PG8_LDA(At, 1, 1); PG8_STAGE(PG8_SB(1, 0), b3, voffB); PG8_STAGE(PG8_SB(1, 1), b3 + hstep, voffB); PG8_STAGE(PG8_SA(1, 0), a3, voffA);
            PG8_WAIT_V(8); PG8_WAIT_L(0); PG8_BAR; PG8_MMA(1, 0, At, B0); PG8_MMA(1, 1, At, B1); PG8_BAR; PG8_SCHED;
            } else {
            PG8_LDB(B0, 0, 0); PG8_SCHED; PG8_LDA(At, 0, 0); PG8_STAGE(PG8_SA(1, 1), a1 + hstep, voffA);
            PG8_WAIT_L(8); PG8_BAR; PG8_WAIT_L(0); PG8_MMA(0, 0, At, B0); PG8_BAR; PG8_SCHED;
            PG8_LDB(B1, 0, 1); PG8_STAGE(PG8_SB(0, 0), b2, voffB);
            PG8_BAR; PG8_WAIT_L(0); PG8_MMA(0, 1, At, B1); PG8_BAR;
            PG8_LDA(At, 0, 1); PG8_STAGE(PG8_SA(0, 0), a2, voffA);
            PG8_BAR; PG8_WAIT_L(0); PG8_MMA(1, 0, At, B0); PG8_BAR; PG8_SCHED;
            PG8_STAGE(PG8_SB(0, 1), b2 + hstep, voffB);
            PG8_WAIT_V(6); PG8_BAR; PG8_MMA(1, 1, At, B1); PG8_BAR;
            PG8_LDB(B0, 1, 0); PG8_SCHED; PG8_LDA(At, 1, 0); PG8_STAGE(PG8_SA(0, 1), a2 + hstep, voffA);
            PG8_WAIT_L(8); PG8_BAR; PG8_WAIT_L(0); PG8_MMA(0, 0, At, B0); PG8_BAR; PG8_SCHED;
            PG8_LDB(B1, 1, 1); PG8_STAGE(PG8_SB(1, 0), b3, voffB);
            PG8_BAR; PG8_WAIT_L(0); PG8_MMA(0, 1, At, B1); PG8_BAR;
            PG8_LDA(At, 1, 1); PG8_STAGE(PG8_SA(1, 0), a3, voffA);
            PG8_BAR; PG8_WAIT_L(0); PG8_MMA(1, 0, At, B0); PG8_BAR; PG8_SCHED;
            PG8_STAGE(PG8_SB(1, 1), b3 + hstep, voffB);
            PG8_WAIT_V(6); PG8_BAR; PG8_MMA(1, 1, At, B1); PG8_BAR;
            }
        }
        if constexpr (ALIGN_EPI) { if (wr == 0) PG8_BAR; }
        if constexpr (!Epi::AFTER_DRAIN) { E(acc, cur, wr, wc, fr, fq); S.done(cur); }
        if (!has_next) break;
#pragma unroll
        for (int a = 0; a < 2; ++a)
#pragma unroll
            for (int b = 0; b < 2; ++b)
#pragma unroll
                for (int m = 0; m < 4; ++m)
#pragma unroll
                    for (int n = 0; n < 2; ++n) acc[a][b][m][n] = (f32x4){0.f, 0.f, 0.f, 0.f};
        cur = nxt; cA = nA; cB = nB; ++ui;
        if constexpr (ALIGN_EPI) { if (wr == 1) PG8_BAR; }
    }
    PG8_WAIT_V(0);
    if constexpr (!ALIGN_EPI) { if (wr == 0) PG8_BAR; }
    PG8_BAR;
    if constexpr (Epi::AFTER_DRAIN) { E.fused(acc, cur, wr, wc, fr, fq, lds, wid, lane); S.done(cur); }
#undef PG8_SA
#undef PG8_SB
#undef PG8_STAGE
#undef PG8_LDA
#undef PG8_LDB
#undef PG8_MMA
#undef PG8_WAIT_V
#undef PG8_WAIT_L
#undef PG8_BAR
#undef PG8_SCHED
}
}

#ifndef PG8_SP2
#define PG8_SP2 true
#endif
#ifndef PG8_ALIGN
#define PG8_ALIGN true
#endif
#ifndef MK_ONE_LAUNCH
#define MK_ONE_LAUNCH 1
#endif

constexpr int NWAVES = 8;
constexpr int T = 8192, D = 2048, DEPTH = 4, NA = 2;
constexpr int SGW = 4096, SGG = 16, SGD = 256, CHUNK = 128;
constexpr int DFF = 5632, DFF2 = 11264;
constexpr int NH = 16, HD = 128, NKV = 4, NKVC = 3072;
constexpr int NCMP = 511, NSLC = 128, WIN = 512;
constexpr int NQG = 2096;
constexpr int NMOD = 12288;
constexpr float EPS = 1e-6f;
constexpr float NEGBIG = -1e30f;

constexpr size_t MiB = 1u << 20;
constexpr size_t WS_CTL = 0, CTL_ZERO_BYTES = 1 * MiB;
constexpr size_t WS_MODS = 1 * MiB;
constexpr size_t WS_KVMOD = WS_MODS + 4 * NMOD * 4;
constexpr size_t WS_POSB = WS_KVMOD + 4096 * 4;
constexpr size_t WS_WSB = 2 * MiB;
constexpr size_t WS_SSP = 3 * MiB;
constexpr size_t WS_GATES = 4 * MiB;
constexpr size_t WS_KC = 6 * MiB, WS_VC = 7 * MiB;
constexpr size_t WS_WT_SGIN = 16 * MiB;
constexpr size_t WS_WT_SGOUT = 80 * MiB;
constexpr size_t WS_WT_UP = 112 * MiB;
constexpr size_t WS_WT_DOWN = 288 * MiB;
constexpr size_t WS_WT_KV = 376 * MiB;
constexpr size_t WS_WT_Q = 388 * MiB;
constexpr size_t WS_WT_O = 404 * MiB;
constexpr size_t WS_XA = 420 * MiB, WS_XB = 484 * MiB;
constexpr size_t WS_H = 548 * MiB, WS_HKV = 580 * MiB;
constexpr size_t WS_U = 612 * MiB, WS_VT = 676 * MiB, WS_US = 740 * MiB;
constexpr size_t WS_Z = 804 * MiB;
constexpr size_t WS_G = 980 * MiB;
constexpr size_t WS_KV = 1068 * MiB;
constexpr size_t WS_Q = 1116 * MiB, WS_ATT = 1148 * MiB;
constexpr size_t WS_END = 1180 * MiB;
constexpr int CW_BAR = 4096;

constexpr int RING_OFF = 0, RING_BYTES = 131072;
constexpr int LDSCTL_OFF = RING_BYTES, MISC_OFF = LDSCTL_OFF + 320;
constexpr int LDS_BYTES = 147456;
static_assert(MISC_OFF + 128 <= LDS_BYTES, "LDS map");

#define GAS __attribute__((address_space(1)))
#define LAS __attribute__((address_space(3)))
typedef unsigned short bf16;
typedef unsigned v4u __attribute__((ext_vector_type(4)));
typedef unsigned v2u __attribute__((ext_vector_type(2)));
typedef float f32x4 __attribute__((ext_vector_type(4)));
typedef short bf16x8 __attribute__((ext_vector_type(8)));
typedef GAS unsigned gu32;
#define RLX_AGENT __ATOMIC_RELAXED, __HIP_MEMORY_SCOPE_AGENT
#define LDS_WAIT() asm volatile("s_waitcnt lgkmcnt(0)" ::: "memory")
#define VM_WAIT() asm volatile("s_waitcnt vmcnt(0)" ::: "memory")
__device__ __forceinline__ unsigned f2bf(float f) { unsigned u = __builtin_bit_cast(unsigned, f); return (u + 0x7fffu + ((u >> 16) & 1u)) >> 16; }
__device__ __forceinline__ unsigned pk2(float lo, float hi) { return f2bf(lo) | (f2bf(hi) << 16); }
__device__ __forceinline__ float bflo(unsigned w) { return __builtin_bit_cast(float, w << 16); }
__device__ __forceinline__ float bfhi(unsigned w) { return __builtin_bit_cast(float, w & 0xffff0000u); }
__device__ __forceinline__ float bf1(bf16 b) { return __builtin_bit_cast(float, (unsigned)b << 16); }
__device__ __forceinline__ float silu_f(float v) { return v * __builtin_amdgcn_rcpf(1.0f + __builtin_amdgcn_exp2f(-1.4426950409f * v)); }
__device__ __forceinline__ float sigmoid_f(float v) { return __builtin_amdgcn_rcpf(1.0f + __builtin_amdgcn_exp2f(-1.4426950409f * v)); }

#define XB_TMO      128
#define XB_XCNT(j)  (256  + 64 * (j))
#define XB_XSUB(j)  (1280 + 64 * (j))
#define XB_XGEN(j)  (2304 + 64 * (j))
#define XB_TOP      3328
#define XB_TOPGEN   3392
#define XCD_BAR_WORDS 3456
#define XB_SPIN_CAP (1u << 18)

__device__ __forceinline__ unsigned xb_ld(unsigned* p)              { return __hip_atomic_load(p, __ATOMIC_RELAXED, __HIP_MEMORY_SCOPE_AGENT); }
__device__ __forceinline__ unsigned xb_add(unsigned* p, unsigned v) { return __hip_atomic_fetch_add(p, v, __ATOMIC_RELAXED, __HIP_MEMORY_SCOPE_AGENT); }
__device__ __forceinline__ unsigned xb_xcc_id() { return (unsigned)__builtin_amdgcn_s_getreg((3 << 11) | 20) & 0xFu; }
#define XB_SPIN(cond, bar) do { unsigned _sp = 0; while (cond) { __builtin_amdgcn_s_sleep(1); \
    if ((++_sp & 255u) == 0u) { if (xb_ld(&(bar)[XB_TMO])) break; if (_sp > XB_SPIN_CAP) { atomicAdd(&(bar)[XB_TMO], 1u); break; } } } } while (0)

struct XcdBarrier {
    unsigned* bar; unsigned x;
    volatile LAS unsigned* st;
};

__device__ __forceinline__ XcdBarrier xcd_barrier_post(unsigned* bar, volatile LAS unsigned* st) {
    XcdBarrier b; b.bar = bar; b.x = xb_xcc_id(); b.st = st;
    if (threadIdx.x == 0) (void)xb_add(&bar[XB_XCNT(b.x)], 1u);
    return b;
}
__device__ __forceinline__ void xcd_barrier_complete(unsigned* bar, unsigned x, unsigned& nloc, unsigned& nx) {
    const unsigned G = gridDim.x * gridDim.y * gridDim.z;
    unsigned sum, cnt, mine, sp = 0u;
    for (;;) {
        sum = 0u; cnt = 0u; mine = 0u;
#pragma unroll
        for (unsigned j = 0; j < 16; ++j) { const unsigned c = xb_ld(&bar[XB_XCNT(j)]); sum += c; cnt += (c > 0u) ? 1u : 0u; mine = (j == x) ? c : mine; }
        if (sum == G) break;
        __builtin_amdgcn_s_sleep(1);
        if ((++sp & 255u) == 0u) { if (xb_ld(&bar[XB_TMO])) break; if (sp > XB_SPIN_CAP) { atomicAdd(&bar[XB_TMO], 1u); break; } }
    }
    nloc = mine > 0u ? mine : 1u; nx = cnt > 0u ? cnt : 1u;
}

__device__ __forceinline__ void xcd_barrier(const XcdBarrier& b) {
    asm volatile("s_waitcnt vmcnt(0)" ::: "memory");
    __syncthreads();
    if (threadIdx.x == 0) {
        unsigned* bar = b.bar;
        __builtin_amdgcn_s_waitcnt(0);
        unsigned nloc = b.st[0], nx = b.st[1];
        if (nloc == 0u) { xcd_barrier_complete(bar, b.x, nloc, nx); b.st[0] = nloc; b.st[1] = nx; }
        const unsigned old = xb_add(&bar[XB_XSUB(b.x)], 1u);
        const unsigned gen = old / nloc;
        if (old + 1u == (gen + 1u) * nloc) {
            __builtin_amdgcn_fence(__ATOMIC_RELEASE, "agent");
            asm volatile("s_waitcnt vmcnt(0)" ::: "memory");
            const unsigned og = xb_add(&bar[XB_TOP], 1u);
            const unsigned tg = og / nx;
            if (og + 1u == (tg + 1u) * nx) xb_add(&bar[XB_TOPGEN], 1u);
            else XB_SPIN(xb_ld(&bar[XB_TOPGEN]) == tg, bar);
            __builtin_amdgcn_fence(__ATOMIC_ACQUIRE, "agent");
            xb_add(&bar[XB_XGEN(b.x)], 1u);
            asm volatile("s_waitcnt vmcnt(0)" ::: "memory");
        } else {
            XB_SPIN(xb_ld(&bar[XB_XGEN(b.x)]) == gen, bar);
            __builtin_amdgcn_fence(__ATOMIC_ACQUIRE, "agent");
            asm volatile("s_waitcnt vmcnt(0)" ::: "memory");
        }
    }
    __syncthreads();
}

struct Frame {
    LAS unsigned char* lds;
    volatile LAS unsigned* MISC;
    gu32* ctl;
    int tid, lane, wave;
    int vcu, G;
    float* out;
    unsigned char* ws;
};
__device__ __forceinline__ const float* in_ptr(const Frame& F, int i) {
    const volatile LAS unsigned* p = (const volatile LAS unsigned*)(F.lds + LDSCTL_OFF) + 2 * i;
    const unsigned lo = __builtin_amdgcn_readfirstlane(p[0]), hi = __builtin_amdgcn_readfirstlane(p[1]);
    return (const float*)(((unsigned long long)hi << 32) | lo);
}
__device__ __forceinline__ float wave_sum(float v) {
#pragma unroll
    for (int o = 1; o < 64; o <<= 1) v += __shfl_xor(v, o);
    return v;
}
__device__ __forceinline__ float wave_max(float v) {
#pragma unroll
    for (int o = 1; o < 64; o <<= 1) v = fmaxf(v, __shfl_xor(v, o));
    return v;
}

__device__ __forceinline__ void p0_transpose_item(const float* W, int ldw, int K, int N, bf16* WT, LAS float* scr, int item, int lane) {
    const int nblk = N / 32, kb = item / nblk, nb = item % nblk, k0 = 64 * kb, n0 = 32 * nb;
#pragma unroll 8
    for (int i = 0; i < 32; ++i) { const int kk = 2 * i + (lane >> 5); scr[kk * 33 + (lane & 31)] = W[(size_t)(k0 + kk) * ldw + n0 + (lane & 31)]; }
    LDS_WAIT(); asm volatile("" ::: "memory");
    const int c = lane & 7;
#pragma unroll
    for (int j = 0; j < 4; ++j) { const int n = (lane >> 3) + 8 * j; const LAS float* s = scr + (8 * c) * 33 + n;
        v4u o; o.x = pk2(s[0 * 33], s[1 * 33]); o.y = pk2(s[2 * 33], s[3 * 33]); o.z = pk2(s[4 * 33], s[5 * 33]); o.w = pk2(s[6 * 33], s[7 * 33]);
        *(GAS v4u*)(WT + (size_t)(n0 + n) * K + k0 + 8 * c) = o; }
    LDS_WAIT(); asm volatile("" ::: "memory");
}
__device__ __forceinline__ void p0_gemv_item(Frame& F, int it) {
    const float* W; const float* bias; float* out; int N; int col0;
    if (it < 192) { const int l = it / 48, cb = it % 48; W = in_ptr(F, 2) + (size_t)l * D * NMOD; N = NMOD; bias = in_ptr(F, 3) + l * NMOD; out = (float*)(F.ws + WS_MODS) + l * NMOD; col0 = cb * 256; }
    else { const int cb = it - 192; W = in_ptr(F, 15); N = 4096; bias = in_ptr(F, 16); out = (float*)(F.ws + WS_KVMOD); col0 = cb * 256; }
    const float* c = in_ptr(F, 1);
    f32x4 acc = (f32x4){0.f, 0.f, 0.f, 0.f};
    const float* wp = W + (size_t)(F.wave * 256) * N + col0 + 4 * F.lane;
#pragma unroll 8
    for (int k = 0; k < 256; ++k) { const float cv = c[F.wave * 256 + k]; const float s = silu_f(cv); const f32x4 w = *(const GAS f32x4*)(wp + (size_t)k * N); acc += s * w; }
    LAS float* red = (LAS float*)F.lds;
    *(LAS f32x4*)(red + F.wave * 256 + 4 * F.lane) = acc;
    __syncthreads();
    if (F.tid < 256) { float s = bias[col0 + F.tid];
#pragma unroll
        for (int w = 0; w < 8; ++w) s += red[w * 256 + F.tid];
        out[col0 + F.tid] = s; }
    __syncthreads();
}
__device__ __forceinline__ void p0_posb_item(Frame& F, int i) {
    const float* pos = in_ptr(F, 18) + i * 4096; const float* W1 = in_ptr(F, 19) + (size_t)i * 4096 * 128;
    float a0 = 0.f, a1 = 0.f;
    for (int k = F.wave * 512; k < F.wave * 512 + 512; ++k) { const float p = pos[k]; a0 += p * W1[k * 128 + F.lane]; a1 += p * W1[k * 128 + 64 + F.lane]; }
    LAS float* red = (LAS float*)F.lds;
    red[F.wave * 128 + F.lane] = a0; red[F.wave * 128 + 64 + F.lane] = a1;
    __syncthreads();
    if (F.tid < 128) { float s = 0.f;
#pragma unroll
        for (int w = 0; w < 8; ++w) s += red[w * 128 + F.tid];
        ((float*)(F.ws + WS_POSB))[i * 128 + F.tid] = s; }
    __syncthreads();
}
__device__ __forceinline__ void p0_prologue(Frame& F) {
    for (int it = F.vcu; it < 210; it += F.G) { if (it < 208) p0_gemv_item(F, it); else p0_posb_item(F, it - 208); }
    { const float* ws_ = in_ptr(F, 11); bf16* o = (bf16*)(F.ws + WS_WSB);
      for (int i = F.vcu * 512 + F.tid; i < 2 * 16 * 128 * 128; i += F.G * 512) { const int s = i & 127, t = (i >> 7) & 127; o[i] = (s <= t) ? (bf16)f2bf(ws_[i]) : (bf16)0; } }
    LAS float* scr = (LAS float*)(F.lds + RING_OFF + F.wave * 16384);
    const int gw = F.vcu * NWAVES + F.wave, NGW = F.G * NWAVES;
    constexpr int I_SGIN = (D / 64) * (2 * SGW / 32), I_SGOUT = (SGW / 64) * (D / 32), I_UP = (D / 64) * (DFF2 / 32), I_DOWN = (DFF / 64) * (D / 32);
    constexpr int I_KV = (D / 64) * (NKVC / 32), I_Q = (D / 64) * (D / 32), I_O = I_Q;
    constexpr int NITEMS = 2 * I_SGIN + 2 * I_SGOUT + 4 * I_UP + 4 * I_DOWN + I_KV + 2 * I_Q + 2 * I_O;
    for (int it = gw; it < NITEMS; it += NGW) {
        int r = it;
        if (r < 2 * I_SGIN) { const int a = r / I_SGIN; r -= a * I_SGIN; p0_transpose_item(in_ptr(F, 9) + (size_t)a * D * 2 * SGW, 2 * SGW, D, 2 * SGW, (bf16*)(F.ws + WS_WT_SGIN) + (size_t)a * 2 * SGW * D, scr, r, F.lane); continue; } r -= 2 * I_SGIN;
        if (r < 2 * I_SGOUT) { const int a = r / I_SGOUT; r -= a * I_SGOUT; p0_transpose_item(in_ptr(F, 13) + (size_t)a * SGW * D, D, SGW, D, (bf16*)(F.ws + WS_WT_SGOUT) + (size_t)a * D * SGW, scr, r, F.lane); continue; } r -= 2 * I_SGOUT;
        if (r < 4 * I_UP) { const int a = r / I_UP; r -= a * I_UP; p0_transpose_item(in_ptr(F, 5) + (size_t)a * D * DFF2, DFF2, D, DFF2, (bf16*)(F.ws + WS_WT_UP) + (size_t)a * DFF2 * D, scr, r, F.lane); continue; } r -= 4 * I_UP;
        if (r < 4 * I_DOWN) { const int a = r / I_DOWN; r -= a * I_DOWN; p0_transpose_item(in_ptr(F, 8) + (size_t)a * DFF * D, D, DFF, D, (bf16*)(F.ws + WS_WT_DOWN) + (size_t)a * D * DFF, scr, r, F.lane); continue; } r -= 4 * I_DOWN;
        if (r < I_KV) { p0_transpose_item(in_ptr(F, 17), NKVC, D, NKVC, (bf16*)(F.ws + WS_WT_KV), scr, r, F.lane); continue; } r -= I_KV;
        if (r < 2 * I_Q) { const int a = r / I_Q; r -= a * I_Q; p0_transpose_item(in_ptr(F, 22) + (size_t)a * D * NQG, NQG, D, D, (bf16*)(F.ws + WS_WT_Q) + (size_t)a * D * D, scr, r, F.lane); continue; } r -= 2 * I_Q;
        { const int a = r / I_O; r -= a * I_O; p0_transpose_item(in_ptr(F, 24) + (size_t)a * D * D, D, D, D, (bf16*)(F.ws + WS_WT_O) + (size_t)a * D * D, scr, r, F.lane); }
    }
}

template <bool DUAL>
__device__ __forceinline__ void rowmod_phase(Frame& F, const float* x, const float* gain, const float* shift, const float* scale, bf16* out,
                                             const float* gain2, const float* shift2, const float* scale2, bf16* out2) {
    const int gw = F.vcu * NWAVES + F.wave, NGW = F.G * NWAVES;
    f32x4 ca[8], cb[8], ca2[8], cb2[8];
#pragma unroll
    for (int j = 0; j < 8; ++j) { const int c = 4 * F.lane + 256 * j;
        const f32x4 g = *(const GAS f32x4*)(gain + c), sc = *(const GAS f32x4*)(scale + c); ca[j] = g * (sc + 1.0f); cb[j] = *(const GAS f32x4*)(shift + c);
        if (DUAL) { const f32x4 g2 = *(const GAS f32x4*)(gain2 + c), sc2 = *(const GAS f32x4*)(scale2 + c); ca2[j] = g2 * (sc2 + 1.0f); cb2[j] = *(const GAS f32x4*)(shift2 + c); } }
    for (int m = gw; m < T; m += NGW) {
        const GAS f32x4* xr = (const GAS f32x4*)(x + (size_t)m * D) + F.lane;
        f32x4 v[8]; float s = 0.f;
#pragma unroll
        for (int j = 0; j < 8; ++j) { v[j] = xr[64 * j]; s += (v[j].x * v[j].x + v[j].y * v[j].y) + (v[j].z * v[j].z + v[j].w * v[j].w); }
        const float rstd = 1.0f / sqrtf(wave_sum(s) * (1.0f / D) + EPS);
        GAS v2u* o8 = (GAS v2u*)(out + (size_t)m * D) + F.lane;
#pragma unroll
        for (int j = 0; j < 8; ++j) { const f32x4 y = v[j] * rstd * ca[j] + cb[j]; v2u w; w.x = pk2(y.x, y.y); w.y = pk2(y.z, y.w); o8[64 * j] = w; }
        if (DUAL) { GAS v2u* p8 = (GAS v2u*)(out2 + (size_t)m * D) + F.lane;
#pragma unroll
            for (int j = 0; j < 8; ++j) { const f32x4 y = v[j] * rstd * ca2[j] + cb2[j]; v2u w; w.x = pk2(y.x, y.y); w.y = pk2(y.z, y.w); p8[64 * j] = w; } }
    }
}

__device__ __forceinline__ void colss_phase(Frame& F) {
    const bf16* VT = (const bf16*)(F.ws + WS_VT); float* SSP = (float*)(F.ws + WS_SSP);
    LAS float* red = (LAS float*)F.lds;
    for (int it = F.vcu; it < 512; it += F.G) {
        const int tb = it >> 5, cb = it & 31; const int t0 = tb * 512 + 8 * F.lane;
        float a[8];
#pragma unroll
        for (int e = 0; e < 8; ++e) a[e] = 0.f;
#pragma unroll 4
        for (int i = 0; i < 16; ++i) { const v4u v = *(const GAS v4u*)(VT + (size_t)(cb * 128 + F.wave * 16 + i) * T + t0);
            const unsigned w[4] = {v.x, v.y, v.z, v.w};
#pragma unroll
            for (int q = 0; q < 4; ++q) { const float lo = bflo(w[q]), hi = bfhi(w[q]); a[2 * q] += lo * lo; a[2 * q + 1] += hi * hi; } }
#pragma unroll
        for (int e = 0; e < 8; ++e) red[F.wave * 512 + 8 * F.lane + e] = a[e];
        __syncthreads();
        { float s = 0.f;
#pragma unroll
          for (int w = 0; w < 8; ++w) s += red[w * 512 + F.tid];
          SSP[(size_t)cb * T + tb * 512 + F.tid] = s; }
        __syncthreads();
    }
}
__device__ __forceinline__ void spatial_phase(Frame& F, int a) {
    const bf16* Wc = (const bf16*)(F.ws + WS_WSB) + (size_t)a * 16 * 128 * 128; const float* vgain = in_ptr(F, 10) + a * SGW; const float* bs = in_ptr(F, 12) + a * 16 * 128;
    const bf16* VT = (const bf16*)(F.ws + WS_VT); const bf16* U = (const bf16*)(F.ws + WS_U); bf16* US = (bf16*)(F.ws + WS_US); const float* SSP = (const float*)(F.ws + WS_SSP);
    LAS float* rsl = (LAS float*)F.lds;
    const int wr = F.wave >> 2, wc = F.wave & 3, fr = F.lane & 15, fq = F.lane >> 4;
    for (int unit = F.vcu; unit < 64 * 16; unit += F.G) {
        const int n = unit >> 4, g = unit & 15;
        __syncthreads();
        if (F.tid < 128) { float ss = 0.f;
#pragma unroll 8
            for (int cb = 0; cb < 32; ++cb) ss += SSP[(size_t)cb * T + n * 128 + F.tid];
            rsl[F.tid] = 1.0f / sqrtf(ss * (1.0f / SGW) + EPS); }
        __syncthreads();
        f32x4 acc[4][4];
#pragma unroll
        for (int mi = 0; mi < 4; ++mi)
#pragma unroll
            for (int ni = 0; ni < 4; ++ni) acc[mi][ni] = (f32x4){0.f, 0.f, 0.f, 0.f};
#pragma unroll
        for (int ks = 0; ks < 4; ++ks) {
            if (ks * 32 > wr * 64 + 63) continue;
            float rs[8];
#pragma unroll
            for (int j = 0; j < 8; ++j) rs[j] = rsl[ks * 32 + 8 * fq + j];
            bf16x8 af[4], bfr[4];
#pragma unroll
            for (int mi = 0; mi < 4; ++mi) { const v4u w = *(const GAS v4u*)(Wc + ((size_t)(g * 128 + wr * 64 + mi * 16 + fr) * 128 + ks * 32 + 8 * fq));
                v4u o; o.x = pk2(bflo(w.x) * rs[0], bfhi(w.x) * rs[1]); o.y = pk2(bflo(w.y) * rs[2], bfhi(w.y) * rs[3]); o.z = pk2(bflo(w.z) * rs[4], bfhi(w.z) * rs[5]); o.w = pk2(bflo(w.w) * rs[6], bfhi(w.w) * rs[7]);
                af[mi] = __builtin_bit_cast(bf16x8, o); }
#pragma unroll
            for (int ni = 0; ni < 4; ++ni) bfr[ni] = *(const GAS bf16x8*)(VT + (size_t)(g * 256 + wc * 64 + ni * 16 + fr) * T + n * 128 + ks * 32 + 8 * fq);
#pragma unroll
            for (int mi = 0; mi < 4; ++mi)
#pragma unroll
                for (int ni = 0; ni < 4; ++ni) acc[mi][ni] = __builtin_amdgcn_mfma_f32_16x16x32_bf16(bfr[ni], af[mi], acc[mi][ni], 0, 0, 0);
        }
#pragma unroll
        for (int mi = 0; mi < 4; ++mi) { const int t = wr * 64 + mi * 16 + fr; const float bt = bs[g * 128 + t]; const size_t ro = (size_t)(n * 128 + t) * SGW;
#pragma unroll
            for (int ni = 0; ni < 4; ++ni) { const int cc = g * 256 + wc * 64 + ni * 16 + 4 * fq;
                const v2u uu = *(const GAS v2u*)(U + ro + cc); const f32x4 gv = *(const GAS f32x4*)(vgain + cc); const f32x4 val = acc[mi][ni] * gv + bt;
                v2u o; o.x = pk2(bflo(uu.x) * val.x, bfhi(uu.x) * val.y); o.y = pk2(bflo(uu.y) * val.z, bfhi(uu.y) * val.w);
                *(GAS v2u*)(US + ro + cc) = o; } }
    }
}

__device__ __forceinline__ void convgate_phase(Frame& F, int layer) {
    const bf16* Z = (const bf16*)(F.ws + WS_Z); bf16* Gb = (bf16*)(F.ws + WS_G);
    const float* cw = in_ptr(F, 6) + (size_t)layer * 3 * DFF2; const float* cbv = in_ptr(F, 7) + (size_t)layer * DFF2;
    const int gw = F.vcu * NWAVES + F.wave, NGW = F.G * NWAVES;
    for (int it = gw; it < 11 * 256; it += NGW) {
        const int cc = it % 11, rc = it / 11; const int j0 = cc * 512 + 8 * F.lane, t0 = rc * 32;
        float wa[3][8], wv[3][8], ba[8], bv[8];
#pragma unroll
        for (int k = 0; k < 3; ++k)
#pragma unroll
            for (int e = 0; e < 8; ++e) { wa[k][e] = cw[k * DFF2 + j0 + e]; wv[k][e] = cw[k * DFF2 + DFF + j0 + e]; }
#pragma unroll
        for (int e = 0; e < 8; ++e) { ba[e] = cbv[j0 + e]; bv[e] = cbv[DFF + j0 + e]; }
        float a1[8], a2[8], v1[8], v2[8];
#pragma unroll
        for (int e = 0; e < 8; ++e) { a1[e] = 0.f; a2[e] = 0.f; v1[e] = 0.f; v2[e] = 0.f; }
        if (t0 > 0) {
            const v4u pa1 = *(const GAS v4u*)(Z + (size_t)(t0 - 1) * DFF2 + j0), pa2 = *(const GAS v4u*)(Z + (size_t)(t0 - 2) * DFF2 + j0);
            const v4u pv1 = *(const GAS v4u*)(Z + (size_t)(t0 - 1) * DFF2 + DFF + j0), pv2 = *(const GAS v4u*)(Z + (size_t)(t0 - 2) * DFF2 + DFF + j0);
            const unsigned xa1[4] = {pa1.x, pa1.y, pa1.z, pa1.w}, xa2[4] = {pa2.x, pa2.y, pa2.z, pa2.w}, xv1[4] = {pv1.x, pv1.y, pv1.z, pv1.w}, xv2[4] = {pv2.x, pv2.y, pv2.z, pv2.w};
#pragma unroll
            for (int q = 0; q < 4; ++q) { a1[2 * q] = bflo(xa1[q]); a1[2 * q + 1] = bfhi(xa1[q]); a2[2 * q] = bflo(xa2[q]); a2[2 * q + 1] = bfhi(xa2[q]);
                v1[2 * q] = bflo(xv1[q]); v1[2 * q + 1] = bfhi(xv1[q]); v2[2 * q] = bflo(xv2[q]); v2[2 * q + 1] = bfhi(xv2[q]); }
        }
#pragma unroll 2
        for (int t = t0; t < t0 + 32; ++t) {
            const v4u pa = *(const GAS v4u*)(Z + (size_t)t * DFF2 + j0), pv = *(const GAS v4u*)(Z + (size_t)t * DFF2 + DFF + j0);
            const unsigned xa[4] = {pa.x, pa.y, pa.z, pa.w}, xv[4] = {pv.x, pv.y, pv.z, pv.w};
            float a0[8], v0[8], o[8];
#pragma unroll
            for (int q = 0; q < 4; ++q) { a0[2 * q] = bflo(xa[q]); a0[2 * q + 1] = bfhi(xa[q]); v0[2 * q] = bflo(xv[q]); v0[2 * q + 1] = bfhi(xv[q]); }
#pragma unroll
            for (int e = 0; e < 8; ++e) { const float av = ba[e] + wa[0][e] * a2[e] + wa[1][e] * a1[e] + wa[2][e] * a0[e]; const float vv = bv[e] + wv[0][e] * v2[e] + wv[1][e] * v1[e] + wv[2][e] * v0[e];
                o[e] = silu_f(av) * vv; a2[e] = a1[e]; a1[e] = a0[e]; v2[e] = v1[e]; v1[e] = v0[e]; }
            v4u w; w.x = pk2(o[0], o[1]); w.y = pk2(o[2], o[3]); w.z = pk2(o[4], o[5]); w.w = pk2(o[6], o[7]);
            *(GAS v4u*)(Gb + (size_t)t * DFF + j0) = w;
        }
    }
}

constexpr int CMP_WSL = 8192 + 512;
__device__ __forceinline__ void kvpost_phase(Frame& F) {
    bf16* KV = (bf16*)(F.ws + WS_KV); const float* kg = in_ptr(F, 21);
    const int gw = F.vcu * NWAVES + F.wave, NGW = F.G * NWAVES;
    LAS unsigned char* wl = F.lds + F.wave * 16384;
    LAS bf16* al = (LAS bf16*)wl; LAS float* h1 = (LAS float*)(wl + 8192);
    const float* posb = (const float*)(F.ws + WS_POSB);
    for (int it = gw; it < T + 2 * NCMP * 4; it += NGW) {
        if (it < T) {
            const int t = it;
#pragma unroll
            for (int q = 0; q < 2; ++q) { const int tensor = q ? 4 : 2; bf16* p = KV + (size_t)t * NKVC + tensor * 512 + 8 * F.lane;
                const v4u v = *(const GAS v4u*)p; const unsigned w[4] = {v.x, v.y, v.z, v.w}; float x[8]; float ss = 0.f;
#pragma unroll
                for (int e = 0; e < 4; ++e) { x[2 * e] = bflo(w[e]); x[2 * e + 1] = bfhi(w[e]); ss += x[2 * e] * x[2 * e] + x[2 * e + 1] * x[2 * e + 1]; }
                ss += __shfl_xor(ss, 1); ss += __shfl_xor(ss, 2); ss += __shfl_xor(ss, 4); ss += __shfl_xor(ss, 8);
                const float rs = 1.0f / sqrtf(ss * (1.0f / HD) + EPS); const float* gp = kg + (q ? 2 : 1) * HD + ((8 * F.lane) & 127);
                v4u o; o.x = pk2(x[0] * rs * gp[0], x[1] * rs * gp[1]); o.y = pk2(x[2] * rs * gp[2], x[3] * rs * gp[3]); o.z = pk2(x[4] * rs * gp[4], x[5] * rs * gp[5]); o.w = pk2(x[6] * rs * gp[6], x[7] * rs * gp[7]);
                *(GAS v4u*)p = o; }
        } else {
            int r = it - T; const int i = r / (NCMP * 4); r -= i * NCMP * 4; const int n = r >> 2, g = r & 3;
#pragma unroll
            for (int q = 0; q < 8; ++q) { const int idx = F.lane + 64 * q; const int l = idx >> 4, ch = idx & 15;
                const v4u v = *(const GAS v4u*)(KV + (size_t)(16 * n + l) * NKVC + i * 512 + g * 128 + 8 * ch);
                *(LAS v4u*)(al + l * 128 + 8 * ch) = v; }
            LDS_WAIT(); asm volatile("" ::: "memory");
            const float* W1 = in_ptr(F, 19) + (size_t)i * 4096 * 128; const float* W2 = in_ptr(F, 20) + (size_t)i * 128 * 128;
            float a0 = posb[i * 128 + F.lane], a1 = posb[i * 128 + 64 + F.lane];
#pragma unroll 4
            for (int k = 0; k < 4096; k += 2) { const unsigned w = *(const LAS unsigned*)(al + k); const float x0 = bflo(w), x1 = bfhi(w);
                a0 += x0 * W1[k * 128 + F.lane]; a1 += x0 * W1[k * 128 + 64 + F.lane];
                a0 += x1 * W1[(k + 1) * 128 + F.lane]; a1 += x1 * W1[(k + 1) * 128 + 64 + F.lane]; }
            h1[F.lane] = pg8::gelu_tanh(a0); h1[64 + F.lane] = pg8::gelu_tanh(a1);
            LDS_WAIT(); asm volatile("" ::: "memory");
            float o0 = 0.f, o1 = 0.f;
#pragma unroll 8
            for (int k = 0; k < 128; ++k) { const float x = h1[k]; o0 += x * W2[k * 128 + F.lane]; o1 += x * W2[k * 128 + 64 + F.lane]; }
            if (i == 0) { const float ss = wave_sum(o0 * o0 + o1 * o1); const float rs = 1.0f / sqrtf(ss * (1.0f / HD) + EPS); o0 *= rs * kg[F.lane]; o1 *= rs * kg[64 + F.lane]; }
            bf16* dst = (bf16*)(F.ws + (i ? WS_VC : WS_KC)) + (size_t)(g * 512 + n) * HD;
            dst[F.lane] = (bf16)f2bf(o0); dst[64 + F.lane] = (bf16)f2bf(o1);
            LDS_WAIT(); asm volatile("" ::: "memory");
        }
    }
}

__device__ __forceinline__ void gates_phase(Frame& F, int bl) {
    const bf16* H = (const bf16*)(F.ws + WS_H); float* GT = (float*)(F.ws + WS_GATES);
    const float* Wg = in_ptr(F, 22) + (size_t)bl * D * NQG + 2048;
    const int gw = F.vcu * NWAVES + F.wave, NGW = F.G * NWAVES;
    LAS bf16* hl = (LAS bf16*)(F.lds + F.wave * 16384);
    for (int it = gw; it < T / 4; it += NGW) {
        const int t0 = it * 4;
#pragma unroll
        for (int q = 0; q < 16; ++q) { const int idx = F.lane + 64 * q;
            *(LAS v4u*)(hl + idx * 8) = *(const GAS v4u*)(H + (size_t)t0 * D + idx * 8); }
        LDS_WAIT(); asm volatile("" ::: "memory");
        const int col = F.lane < 48 ? F.lane : 47;
        float a0 = 0.f, a1 = 0.f, a2 = 0.f, a3 = 0.f;
#pragma unroll 4
        for (int k = 0; k < D; k += 2) { const float w0 = Wg[(size_t)k * NQG + col], w1 = Wg[(size_t)(k + 1) * NQG + col];
            const unsigned h0 = *(const LAS unsigned*)(hl + k), h1_ = *(const LAS unsigned*)(hl + 2048 + k), h2 = *(const LAS unsigned*)(hl + 4096 + k), h3 = *(const LAS unsigned*)(hl + 6144 + k);
            a0 += bflo(h0) * w0 + bfhi(h0) * w1; a1 += bflo(h1_) * w0 + bfhi(h1_) * w1; a2 += bflo(h2) * w0 + bfhi(h2) * w1; a3 += bflo(h3) * w0 + bfhi(h3) * w1; }
        if (F.lane < 48) { GT[(size_t)(t0 + 0) * 48 + F.lane] = sigmoid_f(a0); GT[(size_t)(t0 + 1) * 48 + F.lane] = sigmoid_f(a1); GT[(size_t)(t0 + 2) * 48 + F.lane] = sigmoid_f(a2); GT[(size_t)(t0 + 3) * 48 + F.lane] = sigmoid_f(a3); }
        LDS_WAIT(); asm volatile("" ::: "memory");
    }
}

constexpr int AN_QS = 0, AN_SC = 2048, AN_RI = AN_SC + 8192, AN_IMP = AN_RI + 2048, AN_SEL = AN_IMP + 512, AN_WSL = 13312;
struct AttnState { float m[4], l[4], o[4][2]; };
template <class KeyMap>
__device__ __forceinline__ void attn_chunk(Frame& F, LAS unsigned char* wl, const bf16* Kb, const bf16* Vb, int rstride, int nk, const KeyMap& km, const float (&slope)[4], AttnState& st) {
    LAS float* qs = (LAS float*)(wl + AN_QS); LAS float* sc = (LAS float*)(wl + AN_SC); LAS int* ri = (LAS int*)(wl + AN_RI);
    const int lane = F.lane;
    for (int j = lane; j < nk; j += 64) {
        int row, dist; km(j, row, dist);
        ri[j] = row;
        float a[4] = {0.f, 0.f, 0.f, 0.f};
        if (dist >= 0) {
            const bf16* kp = Kb + (size_t)row * rstride;
#pragma unroll 4
            for (int c = 0; c < 16; ++c) { const v4u v = *(const GAS v4u*)(kp + 8 * c); const unsigned w[4] = {v.x, v.y, v.z, v.w}; float x[8];
#pragma unroll
                for (int e = 0; e < 4; ++e) { x[2 * e] = bflo(w[e]); x[2 * e + 1] = bfhi(w[e]); }
#pragma unroll
                for (int r = 0; r < 4; ++r) { const f32x4 q0 = *(const LAS f32x4*)(qs + r * 128 + 8 * c), q1 = *(const LAS f32x4*)(qs + r * 128 + 8 * c + 4);
                    a[r] += (x[0] * q0.x + x[1] * q0.y) + (x[2] * q0.z + x[3] * q0.w) + (x[4] * q1.x + x[5] * q1.y) + (x[6] * q1.z + x[7] * q1.w); } }
        }
#pragma unroll
        for (int r = 0; r < 4; ++r) sc[r * 512 + j] = dist >= 0 ? a[r] - slope[r] * (float)dist : NEGBIG;
    }
    LDS_WAIT(); asm volatile("" ::: "memory");
#pragma unroll
    for (int r = 0; r < 4; ++r) {
        float cm = NEGBIG;
        for (int j = lane; j < nk; j += 64) cm = fmaxf(cm, sc[r * 512 + j]);
        cm = wave_max(cm);
        const float mn = fmaxf(st.m[r], cm);
        const float alpha = __expf(st.m[r] - mn);
        float ps = 0.f;
        for (int j = lane; j < nk; j += 64) { const float s = sc[r * 512 + j]; const float p = s > -1e29f ? __expf(s - mn) : 0.f; sc[r * 512 + j] = p; ps += p; }
        ps = wave_sum(ps);
        st.l[r] = st.l[r] * alpha + ps; st.o[r][0] *= alpha; st.o[r][1] *= alpha; st.m[r] = mn;
    }
    LDS_WAIT(); asm volatile("" ::: "memory");
    for (int j = 0; j < nk; ++j) {
        const int row = ri[j];
        const unsigned vv = *(const GAS unsigned*)(Vb + (size_t)row * rstride + 2 * lane); const float v0 = bflo(vv), v1 = bfhi(vv);
#pragma unroll
        for (int r = 0; r < 4; ++r) { const float p = sc[r * 512 + j]; st.o[r][0] += p * v0; st.o[r][1] += p * v1; }
    }
    LDS_WAIT(); asm volatile("" ::: "memory");
}
struct KmCmp { int t; __device__ __forceinline__ void operator()(int j, int& row, int& dist) const { row = j; dist = t - (16 * j + 31); } };
struct KmSlc { int t; const LAS int* sel; int base; __device__ __forceinline__ void operator()(int j, int& row, int& dist) const { const int b = sel[base + (j >> 6)]; const int p = 64 * b + (j & 63); row = p; dist = t - p; } };
struct KmWin { int t; int p0; __device__ __forceinline__ void operator()(int j, int& row, int& dist) const { const int p = p0 + j; row = p; dist = t - p; } };

__device__ __forceinline__ void attn_naive_phase(Frame& F, int bl) {
    const bf16* Q = (const bf16*)(F.ws + WS_Q); const bf16* KV = (const bf16*)(F.ws + WS_KV); const bf16* KC = (const bf16*)(F.ws + WS_KC); const bf16* VC = (const bf16*)(F.ws + WS_VC);
    const float* GT = (const float*)(F.ws + WS_GATES); bf16* ATT = (bf16*)(F.ws + WS_ATT); const float* qg = in_ptr(F, 23) + bl * HD;
    const int gw = F.vcu * NWAVES + F.wave, NGW = F.G * NWAVES; const int lane = F.lane;
    LAS unsigned char* wl = F.lds + F.wave * AN_WSL;
    LAS float* qs = (LAS float*)(wl + AN_QS); LAS float* sc = (LAS float*)(wl + AN_SC); LAS float* imp = (LAS float*)(wl + AN_IMP); LAS int* sel = (LAS int*)(wl + AN_SEL);
    const float qscale = 0.08838834764831845f;
    for (int item = gw; item < T * 4; item += NGW) {
        const int t = item >> 2, g = item & 3;
        float slope[4];
#pragma unroll
        for (int r = 0; r < 4; ++r) {
            slope[r] = __builtin_amdgcn_exp2f(-0.5f * (float)(g * 4 + r + 1));
            const unsigned w = *(const GAS unsigned*)(Q + (size_t)t * D + (g * 4 + r) * HD + 2 * lane); const float q0 = bflo(w), q1 = bfhi(w);
            const float ss = wave_sum(q0 * q0 + q1 * q1); const float rs = 1.0f / sqrtf(ss * (1.0f / HD) + EPS) * qscale;
            qs[r * 128 + 2 * lane] = q0 * rs * qg[2 * lane]; qs[r * 128 + 2 * lane + 1] = q1 * rs * qg[2 * lane + 1]; }
        LDS_WAIT(); asm volatile("" ::: "memory");
        float outv[4][2];
        { int nv = t >= 31 ? ((t - 31) >> 4) + 1 : 0; if (nv > NCMP) nv = NCMP;
          AttnState st;
#pragma unroll
          for (int r = 0; r < 4; ++r) { st.m[r] = NEGBIG; st.l[r] = 0.f; st.o[r][0] = 0.f; st.o[r][1] = 0.f; }
          imp[lane] = 0.f; imp[64 + lane] = 0.f;
          if (nv > 0) {
              KmCmp km{t};
              attn_chunk(F, wl, KC + (size_t)g * 512 * HD, VC + (size_t)g * 512 * HD, HD, nv, km, slope, st);
              float inv[4];
#pragma unroll
              for (int r = 0; r < 4; ++r) inv[r] = 1.0f / fmaxf(st.l[r], 1e-30f);
#pragma unroll
              for (int h = 0; h < 2; ++h) { const int s = lane + 64 * h; float a = 0.f;
                  for (int n = 4 * s - 1; n <= 4 * s + 3; ++n) if (n >= 0 && n < nv) { a += sc[n] * inv[0] + sc[512 + n] * inv[1] + sc[1024 + n] * inv[2] + sc[1536 + n] * inv[3]; }
                  imp[s] = a; }
          }
          LDS_WAIT(); asm volatile("" ::: "memory");
#pragma unroll
          for (int r = 0; r < 4; ++r) { const float gt = GT[(size_t)t * 48 + 0 * 16 + g * 4 + r]; const float inv = 1.0f / fmaxf(st.l[r], 1e-30f); outv[r][0] = gt * st.o[r][0] * inv; outv[r][1] = gt * st.o[r][1] * inv; }
        }
        const int cur = t >> 6; int nsel;
        if (cur < 16) { nsel = cur + 1; if (lane < 16) sel[lane] = lane; }
        else {
            nsel = 16;
            float v0 = imp[lane], v1 = imp[64 + lane];
            { const int s0 = lane, s1 = lane + 64; if (s0 < 1 || s0 > cur - 2) v0 = -1.f; if (s1 > cur - 2) v1 = -1.f; }
            if (lane == 0) { sel[0] = 0; sel[1] = cur; sel[2] = cur - 1; }
            for (int k = 0; k < 13; ++k) {
                const float mx = wave_max(fmaxf(v0, v1));
                const unsigned long long b0 = __ballot(v0 == mx), b1 = __ballot(v1 == mx);
                const int idx = b0 ? (int)__builtin_ctzll(b0) : 64 + (int)__builtin_ctzll(b1);
                if (lane == 0) sel[3 + k] = idx;
                if (idx == lane) v0 = -1.f; if (idx == lane + 64) v1 = -1.f;
            }
        }
        LDS_WAIT(); asm volatile("" ::: "memory");
        { AttnState st;
#pragma unroll
          for (int r = 0; r < 4; ++r) { st.m[r] = NEGBIG; st.l[r] = 0.f; st.o[r][0] = 0.f; st.o[r][1] = 0.f; }
          for (int c0 = 0; c0 < nsel; c0 += 8) { const int nb = (nsel - c0) < 8 ? (nsel - c0) : 8; KmSlc km{t, sel, c0};
              attn_chunk(F, wl, KV + 2 * 512 + g * HD, KV + 3 * 512 + g * HD, NKVC, nb * 64, km, slope, st); }
#pragma unroll
          for (int r = 0; r < 4; ++r) { const float gt = GT[(size_t)t * 48 + 1 * 16 + g * 4 + r]; const float inv = 1.0f / fmaxf(st.l[r], 1e-30f); outv[r][0] += gt * st.o[r][0] * inv; outv[r][1] += gt * st.o[r][1] * inv; }
        }
        { AttnState st;
#pragma unroll
          for (int r = 0; r < 4; ++r) { st.m[r] = NEGBIG; st.l[r] = 0.f; st.o[r][0] = 0.f; st.o[r][1] = 0.f; }
          const int p0 = t - (WIN - 1) > 0 ? t - (WIN - 1) : 0; KmWin km{t, p0};
          attn_chunk(F, wl, KV + 4 * 512 + g * HD, KV + 5 * 512 + g * HD, NKVC, t - p0 + 1, km, slope, st);
#pragma unroll
          for (int r = 0; r < 4; ++r) { const float gt = GT[(size_t)t * 48 + 2 * 16 + g * 4 + r]; const float inv = 1.0f / fmaxf(st.l[r], 1e-30f); outv[r][0] += gt * st.o[r][0] * inv; outv[r][1] += gt * st.o[r][1] * inv; }
        }
#pragma unroll
        for (int r = 0; r < 4; ++r) *(GAS unsigned*)(ATT + (size_t)t * D + (g * 4 + r) * HD + 2 * lane) = pk2(outv[r][0], outv[r][1]);
    }
}

struct Args { const float* in[25]; float* out; unsigned char* ws; int ph_lo, ph_hi; };
constexpr int NPHASES = 37;
__global__ void __launch_bounds__(NWAVES * 64, 2) yoco_fwd(Args args) {
    extern __shared__ __attribute__((aligned(16))) unsigned char lds[];
    Frame F;
    F.lds = (LAS unsigned char*)lds;
    F.MISC = (volatile LAS unsigned*)(F.lds + MISC_OFF);
    F.tid = threadIdx.x; F.lane = F.tid & 63; F.wave = __builtin_amdgcn_readfirstlane(F.tid >> 6);
    F.G = gridDim.x; { const int bx = blockIdx.x; F.vcu = (F.G % 8 == 0) ? (bx % 8) * (F.G / 8) + bx / 8 : bx; }
    F.ws = args.ws; F.ctl = (gu32*)(args.ws + WS_CTL); F.out = args.out;
    for (int u = F.tid; u < (LDS_BYTES - LDSCTL_OFF) / 4; u += NWAVES * 64) ((LAS unsigned*)(F.lds + LDSCTL_OFF))[u] = 0u;
    __syncthreads();
    if (F.tid < 25) { const unsigned long long pv = (unsigned long long)args.in[F.tid]; volatile LAS unsigned* p = (volatile LAS unsigned*)(F.lds + LDSCTL_OFF) + 2 * F.tid; p[0] = (unsigned)pv; p[1] = (unsigned)(pv >> 32); }
    __syncthreads();
    const int lo = args.ph_lo, hi = args.ph_hi;
    XcdBarrier bar; bar.bar = (unsigned*)(F.ctl + CW_BAR); bar.x = 0; bar.st = nullptr;
    if (hi - lo > 1) bar = xcd_barrier_post((unsigned*)(F.ctl + CW_BAR), F.MISC + 8);
    int pc = 0;
#define PH_BEGIN if (lo <= pc && pc < hi) { unsigned char* ws = F.ws; asm volatile("" : "+s"(ws)); \
    { int t_ = threadIdx.x; asm volatile("" : "+v"(t_)); F.tid = t_; F.lane = t_ & 63; F.wave = __builtin_amdgcn_readfirstlane(t_ >> 6); }
#define PH_END } { const bool both_ = (lo <= pc && pc + 1 < hi); ++pc; if (both_) xcd_barrier(bar); }
#define P_HB ((bf16*)(ws + WS_H))
#define P_HKV ((bf16*)(ws + WS_HKV))
#define P_XA ((float*)(ws + WS_XA))
#define P_XB ((float*)(ws + WS_XB))
#define P_MODS ((const float*)(ws + WS_MODS) + (size_t)layer * NMOD)
#define P_NG (in_ptr(F, 4) + (size_t)layer * 2 * D)
#define P_XIN (layer == 0 ? in_ptr(F, 0) : (const float*)P_XB)
#define P_XOUT (layer == DEPTH - 1 ? F.out : P_XB)
#define P_RING (F.lds + RING_OFF)
#define GEMM_CALL(EPI, g, S, E) pg8::gemm_phase<EPI, pg8::StaticOrder, PG8_ALIGN, PG8_SP2>(P_RING, g, S, E, F.tid)

    PH_BEGIN p0_prologue(F); PH_END

    for (int layer = 0; layer < DEPTH; ++layer) {
        PH_BEGIN
            const float* mods = P_MODS;
            if (layer == NA) { const float* kvm = (const float*)(ws + WS_KVMOD); rowmod_phase<true>(F, P_XIN, P_NG, mods, mods + D, P_HB, in_ptr(F, 14), kvm, kvm + D, P_HKV); }
            else rowmod_phase<false>(F, P_XIN, P_NG, mods, mods + D, P_HB, nullptr, nullptr, nullptr, nullptr);
        PH_END
        if (layer < NA) {
            PH_BEGIN
                const bf16* Wt = (const bf16*)(ws + WS_WT_SGIN) + (size_t)layer * 2 * SGW * D;
                { pg8::Gemm g{P_HB, Wt, T, SGW, D}; pg8::StaticOrder S; S.init(T, SGW, F.G, (int)blockIdx.x); pg8::EpiBf16<1> E{(bf16*)(ws + WS_U), SGW};
                  GEMM_CALL(pg8::EpiBf16<1>, g, S, E); }
                { pg8::Gemm g{Wt + (size_t)SGW * D, P_HB, SGW, T, D}; pg8::StaticOrder S; S.init(SGW, T, F.G, (int)blockIdx.x); pg8::EpiBf16<1> E{(bf16*)(ws + WS_VT), T};
                  GEMM_CALL(pg8::EpiBf16<1>, g, S, E); }
            PH_END
            PH_BEGIN colss_phase(F); PH_END
            PH_BEGIN spatial_phase(F, layer); PH_END
            PH_BEGIN
                { pg8::Gemm g{(const bf16*)(ws + WS_US), (const bf16*)(ws + WS_WT_SGOUT) + (size_t)layer * D * SGW, T, D, SGW}; pg8::StaticOrder S; S.init(T, D, F.G, (int)blockIdx.x);
                  pg8::EpiResid E{P_XIN, P_XA, D, P_MODS + 2 * D};
                  GEMM_CALL(pg8::EpiResid, g, S, E); }
            PH_END
        } else {
            if (layer == NA) {
                PH_BEGIN
                    { pg8::Gemm g{P_HKV, (const bf16*)(ws + WS_WT_KV), T, NKVC, D}; pg8::StaticOrder S; S.init(T, NKVC, F.G, (int)blockIdx.x); pg8::EpiBf16<0> E{(bf16*)(ws + WS_KV), NKVC};
                      GEMM_CALL(pg8::EpiBf16<0>, g, S, E); }
                PH_END
                PH_BEGIN kvpost_phase(F); PH_END
            }
            PH_BEGIN
                { pg8::Gemm g{P_HB, (const bf16*)(ws + WS_WT_Q) + (size_t)(layer - NA) * D * D, T, D, D}; pg8::StaticOrder S; S.init(T, D, F.G, (int)blockIdx.x); pg8::EpiBf16<0> E{(bf16*)(ws + WS_Q), D};
                  GEMM_CALL(pg8::EpiBf16<0>, g, S, E); }
                gates_phase(F, layer - NA);
            PH_END
            PH_BEGIN attn_naive_phase(F, layer - NA); PH_END
            PH_BEGIN
                { pg8::Gemm g{(const bf16*)(ws + WS_ATT), (const bf16*)(ws + WS_WT_O) + (size_t)(layer - NA) * D * D, T, D, D}; pg8::StaticOrder S; S.init(T, D, F.G, (int)blockIdx.x);
                  pg8::EpiResid E{P_XIN, P_XA, D, P_MODS + 2 * D};
                  GEMM_CALL(pg8::EpiResid, g, S, E); }
            PH_END
        }
        PH_BEGIN { const float* mods = P_MODS; rowmod_phase<false>(F, P_XA, P_NG + D, mods + 3 * D, mods + 4 * D, P_HB, nullptr, nullptr, nullptr, nullptr); } PH_END
        PH_BEGIN
            { pg8::Gemm g{P_HB, (const bf16*)(ws + WS_WT_UP) + (size_t)layer * DFF2 * D, T, DFF2, D}; pg8::StaticOrder S; S.init(T, DFF2, F.G, (int)blockIdx.x); pg8::EpiBf16<0> E{(bf16*)(ws + WS_Z), DFF2};
              GEMM_CALL(pg8::EpiBf16<0>, g, S, E); }
        PH_END
        PH_BEGIN convgate_phase(F, layer); PH_END
        PH_BEGIN
            { pg8::Gemm g{(const bf16*)(ws + WS_G), (const bf16*)(ws + WS_WT_DOWN) + (size_t)layer * D * DFF, T, D, DFF}; pg8::StaticOrder S; S.init(T, D, F.G, (int)blockIdx.x);
              pg8::EpiResid E{P_XA, P_XOUT, D, P_MODS + 5 * D};
              GEMM_CALL(pg8::EpiResid, g, S, E); }
        PH_END
    }
#undef PH_BEGIN
#undef PH_END
}

extern "C" void kernel_launch(void* const* d_in, const int* in_sizes, int n_in, void* d_out, int out_size, void* d_ws, size_t ws_size, hipStream_t stream) {
    static int grid = 0;
    if (grid == 0) {
        if (n_in != 25 || in_sizes[0] != T * D || out_size != T * D || ws_size < WS_END) { fprintf(stderr, "kernel_launch: unexpected shapes (n_in %d, in0 %d, out %d, ws %zu)\n", n_in, n_in > 0 ? in_sizes[0] : -1, out_size, ws_size); grid = -1; return; }
        int dev = 0, cus = 0, per_cu = 0;
        if (hipGetDevice(&dev) != hipSuccess || hipDeviceGetAttribute(&cus, hipDeviceAttributeMultiprocessorCount, dev) != hipSuccess) { grid = -1; return; }
        if (hipFuncSetAttribute((const void*)yoco_fwd, hipFuncAttributeMaxDynamicSharedMemorySize, LDS_BYTES) != hipSuccess) { fprintf(stderr, "kernel_launch: hipFuncSetAttribute failed\n"); grid = -1; return; }
        if (hipOccupancyMaxActiveBlocksPerMultiprocessor(&per_cu, (const void*)yoco_fwd, NWAVES * 64, LDS_BYTES) != hipSuccess || per_cu < 1)
            fprintf(stderr, "kernel_launch: note: occupancy query reports %d workgroups per CU\n", per_cu);
        (void)hipGetLastError();
        grid = cus;
    }
    if (grid < 0) return;
    if (hipMemsetAsync((char*)d_ws + WS_CTL, 0, CTL_ZERO_BYTES, stream) != hipSuccess) { fprintf(stderr, "kernel_launch: memset failed\n"); return; }
    Args a{};
    for (int i = 0; i < 25; ++i) a.in[i] = (const float*)d_in[i];
    a.out = (float*)d_out; a.ws = (unsigned char*)d_ws;
#if MK_ONE_LAUNCH
    a.ph_lo = 0; a.ph_hi = NPHASES;
    hipLaunchKernelGGL(yoco_fwd, dim3(grid), dim3(NWAVES * 64), LDS_BYTES, stream, a);
#else
    for (int p = 0; p < NPHASES; ++p) { a.ph_lo = p; a.ph_hi = p + 1; hipLaunchKernelGGL(yoco_fwd, dim3(grid), dim3(NWAVES * 64), LDS_BYTES, stream, a); }
#endif
    const hipError_t le = hipPeekAtLastError();
    if (le != hipSuccess) fprintf(stderr, "kernel_launch: launch failed: %s\n", hipGetErrorName(le));
}
```

```cpp
#include <hip/hip_runtime.h>
#include <cstdio>
#include <cstdint>
namespace pg8 {
#define PG8_LAS __attribute__((address_space(3)))
typedef unsigned short bf16_t;
typedef short bf16x8 __attribute__((ext_vector_type(8)));
typedef float f32x4 __attribute__((ext_vector_type(4)));
typedef unsigned u32x4 __attribute__((ext_vector_type(4)));
constexpr int BM = 256, BK = 64, HALF = 128, HTB = HALF * BK * 2  , STAGE_BYTES = 8 * HTB, NXCD = 8, WGM = 8;

__host__ __device__ __forceinline__ int lds_byte(int r, int c) { const int st = (r >> 4) * 2 + (c >> 5), rr = r & 15, cc = c & 31, ob = rr * 64 + cc * 2; return st * 1024 + (ob ^ (((ob >> 9) & 1) << 5)); }
__host__ __device__ __forceinline__ void stage_rc(int b, int& R, int& C) { const int st = b / 1024, sb = b % 1024, swz = sb ^ (((sb >> 9) & 1) << 5); R = (st >> 1) * 16 + swz / 64; C = (st & 1) * 32 + (swz % 64) / 2; }
__host__ __device__ __forceinline__ int perm32(int rho) { const int n = rho >> 4, i = rho & 15; return 8 * (i >> 2) + 4 * n + (i & 3); }

struct Unit { int pm, pn; };
struct Gemm { const bf16_t* A; const bf16_t* Bt; int M, N, K; };

struct StaticOrder {
    int nM, nN, nwg, G, c;
    __host__ __device__ void init(int M, int N, int G_, int c_) { nM = M / BM; nN = N / BM; nwg = nM * nN; G = G_; c = c_; }
    __host__ __device__ bool next(int i, Unit& u) const {
        const long L = (long)i * G + c; if (L >= nwg) return false;
        int wgid = (int)L; { const int q = nwg / NXCD, r = nwg % NXCD, xcd = wgid % NXCD, off = wgid / NXCD; wgid = (xcd < r ? xcd * (q + 1) : r * (q + 1) + (xcd - r) * q) + off; }
        const int nig = WGM * nN, gid = wgid / nig, fm = gid * WGM, gsz = (nM - fm) < WGM ? (nM - fm) : WGM;
        u.pm = fm + ((wgid % nig) % gsz); u.pn = (wgid % nig) / gsz; return true;
    }
    __device__ __forceinline__ void a_ready(const Unit&) const {}
    __device__ __forceinline__ void done(const Unit&) const {}
};


__device__ __forceinline__ unsigned cvt_pk_bf16(float lo, float hi) { unsigned r; asm volatile("v_cvt_pk_bf16_f32 %0, %1, %2" : "=v"(r) : "v"(lo), "v"(hi)); return r; }
__device__ __forceinline__ float gelu_tanh(float v) {
    const float inner = v * (1.0f + 0.044715f * v * v);
    const float e = __builtin_amdgcn_exp2f(-2.3022081997f * inner);
    return v * __builtin_amdgcn_rcpf(1.0f + e);
}
template <int ACT  > struct EpiBf16 {
    static constexpr bool PERM = true, AFTER_DRAIN = false;
    bf16_t* O; int ldc;
    __device__ __forceinline__ void operator()(const f32x4 (&acc)[2][2][4][2], const Unit& u, int wr, int wc, int fr, int fq) const {
        const int row0 = u.pm * BM + wr * 64 + fr; const int col0 = u.pn * BM + wc * 32 + 8 * fq;
#pragma unroll
        for (int ai = 0; ai < 2; ++ai)
#pragma unroll
            for (int m = 0; m < 4; ++m) { bf16_t* rowp = O + (size_t)(row0 + ai * HALF + m * 16) * ldc + col0;
#pragma unroll
                for (int bj = 0; bj < 2; ++bj) { f32x4 v0 = acc[ai][bj][m][0], v1 = acc[ai][bj][m][1];
                    if (ACT == 1) {
#pragma unroll
                        for (int j = 0; j < 4; ++j) { v0[j] = gelu_tanh(v0[j]); v1[j] = gelu_tanh(v1[j]); } }
                    u32x4 w; w.x = cvt_pk_bf16(v0[0], v0[1]); w.y = cvt_pk_bf16(v0[2], v0[3]); w.z = cvt_pk_bf16(v1[0], v1[1]); w.w = cvt_pk_bf16(v1[2], v1[3]);
                    *(u32x4*)(rowp + bj * HALF) = w; } }
    }
};
struct EpiResid {
    static constexpr bool PERM = false, AFTER_DRAIN = false;
    const float* base; float* out; int ldc; const float* gate;
    __device__ __forceinline__ void operator()(const f32x4 (&acc)[2][2][4][2], const Unit& u, int wr, int wc, int fr, int fq) const {
        const int row0 = u.pm * BM + wr * 64 + fr, col0 = u.pn * BM + wc * 32 + 4 * fq;
        f32x4 gv[2][2];
#pragma unroll
        for (int bj = 0; bj < 2; ++bj)
#pragma unroll
            for (int n = 0; n < 2; ++n) gv[bj][n] = *(const f32x4*)(gate + col0 + bj * HALF + n * 16);
#pragma unroll
        for (int ai = 0; ai < 2; ++ai)
#pragma unroll
            for (int m = 0; m < 4; ++m) { const size_t off = (size_t)(row0 + ai * HALF + m * 16) * ldc + col0;
#pragma unroll
                for (int bj = 0; bj < 2; ++bj)
#pragma unroll
                    for (int n = 0; n < 2; ++n) { const f32x4 bs = *(const f32x4*)(base + off + bj * HALF + n * 16);
                        *(f32x4*)(out + off + bj * HALF + n * 16) = bs + gv[bj][n] * acc[ai][bj][m][n]; } }
    }
};
template <class Epi, class Sched, bool ALIGN_EPI = false, bool SP2 = false>
__device__ __forceinline__ void gemm_phase(PG8_LAS unsigned char* lds, const Gemm g, const Sched& S, const Epi& E, const int tid) {
    const int wid = __builtin_amdgcn_readfirstlane(tid >> 6), lane = tid & 63, wr = wid >> 2, wc = wid & 3, fr = lane & 15, fq = lane >> 4;
    const int K = g.K, nt = K / BK;
    unsigned voffA[2], voffB[2];
#pragma unroll
    for (int i = 0; i < 2; ++i) { int R, C; stage_rc(tid * 16 + i * 8192, R, C); const int Rb = Epi::PERM ? ((R & ~31) + perm32(R & 31)) : R;
        voffA[i] = (unsigned)(R * K + C) * 2u; voffB[i] = (unsigned)(Rb * K + C) * 2u; }
    const size_t kstep = (size_t)(BK * 2);
    const size_t hstep = (size_t)HALF * K * 2;
    const size_t tstep = 2 * hstep;
    const unsigned ldsw = (unsigned)wid * 1024u;
    const int aoff = lds_byte(wr * 64 + fr, fq * 8), boff = lds_byte(wc * 32 + fr, fq * 8);
#define PG8_SA(b, h) (((b) * 2 + (h)) * HTB)
#define PG8_SB(b, h) ((4 + (b) * 2 + (h)) * HTB)
#define PG8_STAGE(bufoff, gbase, voff) do { _Pragma("unroll") for (int _i = 0; _i < 2; ++_i) \
        __builtin_amdgcn_global_load_lds((const unsigned*)((const char*)(gbase) + (voff)[_i]), (PG8_LAS unsigned*)(lds + (bufoff) + ldsw + _i * 8192), 16, 0, 0); } while (0)
#define PG8_LDA(dst, b, h) do { _Pragma("unroll") for (int m = 0; m < 4; ++m) _Pragma("unroll") for (int k = 0; k < 2; ++k) dst[m][k] = *(const PG8_LAS bf16x8*)(lds + PG8_SA(b, h) + aoff + m * 2048 + k * 1024); } while (0)
#define PG8_LDB(dst, b, h) do { _Pragma("unroll") for (int n = 0; n < 2; ++n) _Pragma("unroll") for (int k = 0; k < 2; ++k) dst[n][k] = *(const PG8_LAS bf16x8*)(lds + PG8_SB(b, h) + boff + n * 2048 + k * 1024); } while (0)
#define PG8_MMA(ai, bj, At, Bt) do { __builtin_amdgcn_s_setprio(1); _Pragma("unroll") for (int m = 0; m < 4; ++m) _Pragma("unroll") for (int n = 0; n < 2; ++n) _Pragma("unroll") for (int k = 0; k < 2; ++k) \
        acc[ai][bj][m][n] = __builtin_amdgcn_mfma_f32_16x16x32_bf16(Bt[n][k], At[m][k], acc[ai][bj][m][n], 0, 0, 0); __builtin_amdgcn_s_setprio(0); } while (0)
#define PG8_WAIT_V(n) asm volatile("s_waitcnt vmcnt(" #n ")" ::: "memory")
#define PG8_WAIT_L(n) asm volatile("s_waitcnt lgkmcnt(" #n ")" ::: "memory")
#define PG8_BAR __builtin_amdgcn_s_barrier()
#define PG8_SCHED __builtin_amdgcn_sched_barrier(0)
    Unit cur, nxt; int ui = 0;
    if (!S.next(0, cur)) return;
    f32x4 acc[2][2][4][2];
#pragma unroll
    for (int a = 0; a < 2; ++a)
#pragma unroll
        for (int b = 0; b < 2; ++b)
#pragma unroll
            for (int m = 0; m < 4; ++m)
#pragma unroll
                for (int n = 0; n < 2; ++n) acc[a][b][m][n] = (f32x4){0.f, 0.f, 0.f, 0.f};
    bf16x8 At[4][2], B0[2][2], B1[2][2];
    const char* cA = (const char*)g.A + (size_t)cur.pm * tstep; const char* cB = (const char*)g.Bt + (size_t)cur.pn * tstep;
    S.a_ready(cur);
    if constexpr (SP2) {
        PG8_STAGE(PG8_SB(0, 0), cB, voffB); PG8_STAGE(PG8_SB(0, 1), cB + hstep, voffB); PG8_STAGE(PG8_SA(0, 0), cA, voffA); PG8_STAGE(PG8_SA(0, 1), cA + hstep, voffA);
        if (wr == 1) PG8_BAR;
        PG8_WAIT_V(2); PG8_BAR;
        PG8_STAGE(PG8_SB(1, 0), cB + kstep, voffB); PG8_STAGE(PG8_SA(1, 0), cA + kstep, voffA); PG8_STAGE(PG8_SB(1, 1), cB + hstep + kstep, voffB);
        PG8_WAIT_V(6); PG8_BAR;
    } else {
        PG8_STAGE(PG8_SB(0, 0), cB, voffB); PG8_STAGE(PG8_SA(0, 0), cA, voffA); PG8_STAGE(PG8_SB(0, 1), cB + hstep, voffB); PG8_STAGE(PG8_SA(0, 1), cA + hstep, voffA);
        if (wr == 1) PG8_BAR;
        PG8_WAIT_V(4); PG8_BAR;
        PG8_STAGE(PG8_SB(1, 0), cB + kstep, voffB); PG8_STAGE(PG8_SA(1, 0), cA + kstep, voffA); PG8_STAGE(PG8_SB(1, 1), cB + hstep + kstep, voffB);
        PG8_WAIT_V(6); PG8_BAR;
    }
    for (;;) {
        const bool has_next = S.next(ui + 1, nxt);
        const char* nA = has_next ? (const char*)g.A + (size_t)nxt.pm * tstep : cA; const char* nB = has_next ? (const char*)g.Bt + (size_t)nxt.pn * tstep : cB;
        for (int t = 0; t < nt; t += 2) {
            const bool last = (t == nt - 2);
            const char* a1 = cA + (size_t)(t + 1) * kstep;
            const char* a2 = last ? nA : cA + (size_t)(t + 2) * kstep; const char* b2 = last ? nB : cB + (size_t)(t + 2) * kstep;
            const char* a3 = a2 + kstep; const char* b3 = b2 + kstep;
            if (last && has_next) S.a_ready(nxt);
            if constexpr (SP2) {
            PG8_LDB(B0, 0, 0); PG8_LDB(B1, 0, 1); PG8_SCHED; PG8_LDA(At, 0, 0); PG8_STAGE(PG8_SA(1, 1), a1 + hstep, voffA);
            PG8_WAIT_V(8); PG8_WAIT_L(0); PG8_BAR; PG8_MMA(0, 0, At, B0); PG8_MMA(0, 1, At, B1); PG8_BAR; PG8_SCHED;
            PG8_LDA(At, 0, 1); PG8_STAGE(PG8_SB(0, 0), b2, voffB); PG8_STAGE(PG8_SB(0, 1), b2 + hstep, voffB); PG8_STAGE(PG8_SA(0, 0), a2, voffA);
            PG8_WAIT_V(8); PG8_WAIT_L(0); PG8_BAR; PG8_MMA(1, 0, At, B0); PG8_MMA(1, 1, At, B1); PG8_BAR; PG8_SCHED;
            PG8_LDB(B0, 1, 0); PG8_LDB(B1, 1, 1); PG8_SCHED; PG8_LDA(At, 1, 0); PG8_STAGE(PG8_SA(0, 1), a2 + hstep, voffA);
            PG8_WAIT_V(8); PG8_WAIT_L(0); PG8_BAR; PG8_MMA(0, 0, At, B0); PG8_MMA(0, 1, At, B1); PG8_BAR; PG8_SCHED;
            PG8_LDA(At, 1, 1); PG8_STAGE(PG8_SB(1, 0), b3, voffB); PG8_STAGE(PG8_SB(1, 1), b3 + hstep, voffB); PG8_STAGE(PG8_SA(1, 0), a3, voffA);
            PG8_WAIT_V(8); PG8_WAIT_L(0); PG8_BAR; PG8_MMA(1, 0, At, B0); PG8_MMA(1, 1, At, B1); PG8_BAR; PG8_SCHED;
            } else {
            PG8_LDB(B0, 0, 0); PG8_SCHED; PG8_LDA(At, 0, 0); PG8_STAGE(PG8_SA(1, 1), a1 + hstep, voffA);
            PG8_WAIT_L(8); PG8_BAR; PG8_WAIT_L(0); PG8_MMA(0, 0, At, B0); PG8_BAR; PG8_SCHED;
            PG8_LDB(B1, 0, 1); PG8_STAGE(PG8_SB(0, 0), b2, voffB);
            PG8_BAR; PG8_WAIT_L(0); PG8_MMA(0, 1, At, B1); PG8_BAR;
            PG8_LDA(At, 0, 1); PG8_STAGE(PG8_SA(0, 0), a2, voffA);
            PG8_BAR; PG8_WAIT_L(0); PG8_MMA(1, 0, At, B0); PG8_BAR; PG8_SCHED;
            PG8_STAGE(PG8_SB(0, 1), b2 + hstep, voffB);
            PG8_WAIT_V(6); PG8_BAR; PG8_MMA(1, 1, At, B1); PG8_BAR;
            PG8_LDB(B0, 1, 0); PG8_SCHED; PG8_LDA(At, 1, 0); PG8_STAGE(PG8_SA(0, 1), a2 + hstep, voffA);
            PG8_WAIT_L(8); PG8_BAR; PG8_WAIT_L(0); PG8_MMA(0, 0, At, B0); PG8_BAR; PG8_SCHED;
            PG8_LDB(B1, 1, 1); PG8_STAGE(PG8_SB(1, 0), b3, voffB);
            PG8_BAR; PG8_WAIT_L(0); PG8_MMA(0, 1, At, B1); PG8_BAR;
            PG8_LDA(At, 1, 1); PG8_STAGE(PG8_SA(1, 0), a3, voffA);
            PG8_BAR; PG8_WAIT_L(0); PG8_MMA(1, 0, At, B0); PG8_BAR; PG8_SCHED;
            PG8_STAGE(PG8_SB(1, 1), b3 + hstep, voffB);
            PG8_WAIT_V(6); PG8_BAR; PG8_MMA(1, 1, At, B1); PG8_BAR;
            }
        }
        if constexpr (ALIGN_EPI) { if (wr == 0) PG8_BAR; }
        if constexpr (!Epi::AFTER_DRAIN) { E(acc, cur, wr, wc, fr, fq); S.done(cur); }
        if (!has_next) break;
#pragma unroll
        for (int a = 0; a < 2; ++a)
#pragma unroll
            for (int b = 0; b < 2; ++b)
#pragma unroll
                for (int m = 0; m < 4; ++m)
#pragma unroll
                    for (int n = 0; n < 2; ++n) acc[a][b][m][n] = (f32x4){0.f, 0.f, 0.f, 0.f};
        cur = nxt; cA = nA; cB = nB; ++ui;
        if constexpr (ALIGN_EPI) { if (wr == 1) PG8_BAR; }
    }
    PG8_WAIT_V(0);
    if constexpr (!ALIGN_EPI) { if (wr == 0) PG8_BAR; }
    PG8_BAR;
    if constexpr (Epi::AFTER_DRAIN) { E.fused(acc, cur, wr, wc, fr, fq, lds, wid, lane); S.done(cur); }
#undef PG8_SA
#undef PG8_SB
#undef PG8_STAGE
#undef PG8_LDA
#undef PG8_LDB
#undef PG8_MMA
#undef PG8_WAIT_V
#undef PG8_WAIT_L
#undef PG8_BAR
#undef PG8_SCHED
}
}

#ifndef PG8_SP2
#define PG8_SP2 true
#endif
#ifndef PG8_ALIGN
#define PG8_ALIGN true
#endif
#ifndef MK_ONE_LAUNCH
#define MK_ONE_LAUNCH 1
#endif

constexpr int NWAVES = 8;
constexpr int T = 8192, D = 2048, DEPTH = 4, NA = 2;
constexpr int SGW = 4096, SGG = 16, SGD = 256, CHUNK = 128;
constexpr int DFF = 5632, DFF2 = 11264;
constexpr int NH = 16, HD = 128, NKV = 4, NKVC = 3072;
constexpr int NCMP = 511, NSLC = 128, WIN = 512;
constexpr int NQG = 2096;
constexpr int NMOD = 12288;
constexpr float EPS = 1e-6f;
constexpr float NEGBIG = -1e30f;

constexpr size_t MiB = 1u << 20;
constexpr size_t WS_CTL = 0, CTL_ZERO_BYTES = 1 * MiB;
constexpr size_t WS_MODS = 1 * MiB;
constexpr size_t WS_KVMOD = WS_MODS + 4 * NMOD * 4;
constexpr size_t WS_POSB = WS_KVMOD + 4096 * 4;
constexpr size_t WS_WSB = 2 * MiB;
constexpr size_t WS_SSP = 3 * MiB;
constexpr size_t WS_GATES = 4 * MiB;
constexpr size_t WS_KC = 6 * MiB, WS_VC = 7 * MiB;
constexpr size_t WS_WT_SGIN = 16 * MiB;
constexpr size_t WS_WT_SGOUT = 80 * MiB;
constexpr size_t WS_WT_UP = 112 * MiB;
constexpr size_t WS_WT_DOWN = 288 * MiB;
constexpr size_t WS_WT_KV = 376 * MiB;
constexpr size_t WS_WT_Q = 388 * MiB;
constexpr size_t WS_WT_O = 404 * MiB;
constexpr size_t WS_XA = 420 * MiB, WS_XB = 484 * MiB;
constexpr size_t WS_H = 548 * MiB, WS_HKV = 580 * MiB;
constexpr size_t WS_U = 612 * MiB, WS_VT = 676 * MiB, WS_US = 740 * MiB;
constexpr size_t WS_Z = 804 * MiB;
constexpr size_t WS_G = 980 * MiB;
constexpr size_t WS_KV = 1068 * MiB;
constexpr size_t WS_Q = 1116 * MiB, WS_ATT = 1148 * MiB;
constexpr size_t WS_END = 1180 * MiB;
constexpr int CW_BAR = 4096;

constexpr int RING_OFF = 0, RING_BYTES = 131072;
constexpr int LDSCTL_OFF = RING_BYTES, MISC_OFF = LDSCTL_OFF + 320;
constexpr int LDS_BYTES = 147456;
static_assert(MISC_OFF + 128 <= LDS_BYTES, "LDS map");

#define GAS __attribute__((address_space(1)))
#define LAS __attribute__((address_space(3)))
typedef unsigned short bf16;
typedef unsigned v4u __attribute__((ext_vector_type(4)));
typedef unsigned v2u __attribute__((ext_vector_type(2)));
typedef float f32x4 __attribute__((ext_vector_type(4)));
typedef short bf16x8 __attribute__((ext_vector_type(8)));
typedef GAS unsigned gu32;
#define RLX_AGENT __ATOMIC_RELAXED, __HIP_MEMORY_SCOPE_AGENT
#define LDS_WAIT() asm volatile("s_waitcnt lgkmcnt(0)" ::: "memory")
#define VM_WAIT() asm volatile("s_waitcnt vmcnt(0)" ::: "memory")
__device__ __forceinline__ unsigned f2bf(float f) { unsigned u = __builtin_bit_cast(unsigned, f); return (u + 0x7fffu + ((u >> 16) & 1u)) >> 16; }
__device__ __forceinline__ unsigned pk2(float lo, float hi) { return f2bf(lo) | (f2bf(hi) << 16); }
__device__ __forceinline__ float bflo(unsigned w) { return __builtin_bit_cast(float, w << 16); }
__device__ __forceinline__ float bfhi(unsigned w) { return __builtin_bit_cast(float, w & 0xffff0000u); }
__device__ __forceinline__ float bf1(bf16 b) { return __builtin_bit_cast(float, (unsigned)b << 16); }
__device__ __forceinline__ float silu_f(float v) { return v * __builtin_amdgcn_rcpf(1.0f + __builtin_amdgcn_exp2f(-1.4426950409f * v)); }
__device__ __forceinline__ float sigmoid_f(float v) { return __builtin_amdgcn_rcpf(1.0f + __builtin_amdgcn_exp2f(-1.4426950409f * v)); }

#define XB_TMO      128
#define XB_XCNT(j)  (256  + 64 * (j))
#define XB_XSUB(j)  (1280 + 64 * (j))
#define XB_XGEN(j)  (2304 + 64 * (j))
#define XB_TOP      3328
#define XB_TOPGEN   3392
#define XCD_BAR_WORDS 3456
#define XB_SPIN_CAP (1u << 18)

__device__ __forceinline__ unsigned xb_ld(unsigned* p)              { return __hip_atomic_load(p, __ATOMIC_RELAXED, __HIP_MEMORY_SCOPE_AGENT); }
__device__ __forceinline__ unsigned xb_add(unsigned* p, unsigned v) { return __hip_atomic_fetch_add(p, v, __ATOMIC_RELAXED, __HIP_MEMORY_SCOPE_AGENT); }
__device__ __forceinline__ unsigned xb_xcc_id() { return (unsigned)__builtin_amdgcn_s_getreg((3 << 11) | 20) & 0xFu; }
#define XB_SPIN(cond, bar) do { unsigned _sp = 0; while (cond) { __builtin_amdgcn_s_sleep(1); \
    if ((++_sp & 255u) == 0u) { if (xb_ld(&(bar)[XB_TMO])) break; if (_sp > XB_SPIN_CAP) { atomicAdd(&(bar)[XB_TMO], 1u); break; } } } } while (0)

struct XcdBarrier {
    unsigned* bar; unsigned x;
    volatile LAS unsigned* st;
};

__device__ __forceinline__ XcdBarrier xcd_barrier_post(unsigned* bar, volatile LAS unsigned* st) {
    XcdBarrier b; b.bar = bar; b.x = xb_xcc_id(); b.st = st;
    if (threadIdx.x == 0) (void)xb_add(&bar[XB_XCNT(b.x)], 1u);
    return b;
}
__device__ __forceinline__ void xcd_barrier_complete(unsigned* bar, unsigned x, unsigned& nloc, unsigned& nx) {
    const unsigned G = gridDim.x * gridDim.y * gridDim.z;
    unsigned sum, cnt, mine, sp = 0u;
    for (;;) {
        sum = 0u; cnt = 0u; mine = 0u;
#pragma unroll
        for (unsigned j = 0; j < 16; ++j) { const unsigned c = xb_ld(&bar[XB_XCNT(j)]); sum += c; cnt += (c > 0u) ? 1u : 0u; mine = (j == x) ? c : mine; }
        if (sum == G) break;
        __builtin_amdgcn_s_sleep(1);
        if ((++sp & 255u) == 0u) { if (xb_ld(&bar[XB_TMO])) break; if (sp > XB_SPIN_CAP) { atomicAdd(&bar[XB_TMO], 1u); break; } }
    }
    nloc = mine > 0u ? mine : 1u; nx = cnt > 0u ? cnt : 1u;
}

__device__ __forceinline__ void xcd_barrier(const XcdBarrier& b) {
    asm volatile("s_waitcnt vmcnt(0)" ::: "memory");
    __syncthreads();
    if (threadIdx.x == 0) {
        unsigned* bar = b.bar;
        __builtin_amdgcn_s_waitcnt(0);
        unsigned nloc = b.st[0], nx = b.st[1];
        if (nloc == 0u) { xcd_barrier_complete(bar, b.x, nloc, nx); b.st[0] = nloc; b.st[1] = nx; }
        const unsigned old = xb_add(&bar[XB_XSUB(b.x)], 1u);
        const unsigned gen = old / nloc;
        if (old + 1u == (gen + 1u) * nloc) {
            __builtin_amdgcn_fence(__ATOMIC_RELEASE, "agent");
            asm volatile("s_waitcnt vmcnt(0)" ::: "memory");
            const unsigned og = xb_add(&bar[XB_TOP], 1u);
            const unsigned tg = og / nx;
            if (og + 1u == (tg + 1u) * nx) xb_add(&bar[XB_TOPGEN], 1u);
            else XB_SPIN(xb_ld(&bar[XB_TOPGEN]) == tg, bar);
            __builtin_amdgcn_fence(__ATOMIC_ACQUIRE, "agent");
            xb_add(&bar[XB_XGEN(b.x)], 1u);
            asm volatile("s_waitcnt vmcnt(0)" ::: "memory");
        } else {
            XB_SPIN(xb_ld(&bar[XB_XGEN(b.x)]) == gen, bar);
            __builtin_amdgcn_fence(__ATOMIC_ACQUIRE, "agent");
            asm volatile("s_waitcnt vmcnt(0)" ::: "memory");
        }
    }
    __syncthreads();
}

struct Frame {
    LAS unsigned char* lds;
    volatile LAS unsigned* MISC;
    gu32* ctl;
    int tid, lane, wave;
    int vcu, G;
    float* out;
    unsigned char* ws;
};
__device__ __forceinline__ const float* in_ptr(const Frame& F, int i) {
    const volatile LAS unsigned* p = (const volatile LAS unsigned*)(F.lds + LDSCTL_OFF) + 2 * i;
    const unsigned lo = __builtin_amdgcn_readfirstlane(p[0]), hi = __builtin_amdgcn_readfirstlane(p[1]);
    return (const float*)(((unsigned long long)hi << 32) | lo);
}
__device__ __forceinline__ float wave_sum(float v) {
#pragma unroll
    for (int o = 1; o < 64; o <<= 1) v += __shfl_xor(v, o);
    return v;
}
__device__ __forceinline__ float wave_max(float v) {
#pragma unroll
    for (int o = 1; o < 64; o <<= 1) v = fmaxf(v, __shfl_xor(v, o));
    return v;
}

__device__ __forceinline__ void p0_transpose_item(const float* W, int ldw, int K, int N, bf16* WT, LAS float* scr, int item, int lane) {
    const int nblk = N / 32, kb = item / nblk, nb = item % nblk, k0 = 64 * kb, n0 = 32 * nb;
#pragma unroll 8
    for (int i = 0; i < 32; ++i) { const int kk = 2 * i + (lane >> 5); scr[kk * 33 + (lane & 31)] = W[(size_t)(k0 + kk) * ldw + n0 + (lane & 31)]; }
    LDS_WAIT(); asm volatile("" ::: "memory");
    const int c = lane & 7;
#pragma unroll
    for (int j = 0; j < 4; ++j) { const int n = (lane >> 3) + 8 * j; const LAS float* s = scr + (8 * c) * 33 + n;
        v4u o; o.x = pk2(s[0 * 33], s[1 * 33]); o.y = pk2(s[2 * 33], s[3 * 33]); o.z = pk2(s[4 * 33], s[5 * 33]); o.w = pk2(s[6 * 33], s[7 * 33]);
        *(GAS v4u*)(WT + (size_t)(n0 + n) * K + k0 + 8 * c) = o; }
    LDS_WAIT(); asm volatile("" ::: "memory");
}
__device__ __forceinline__ void p0_gemv_item(Frame& F, int it) {
    const float* W; const float* bias; float* out; int N; int col0;
    if (it < 192) { const int l = it / 48, cb = it % 48; W = in_ptr(F, 2) + (size_t)l * D * NMOD; N = NMOD; bias = in_ptr(F, 3) + l * NMOD; out = (float*)(F.ws + WS_MODS) + l * NMOD; col0 = cb * 256; }
    else { const int cb = it - 192; W = in_ptr(F, 15); N = 4096; bias = in_ptr(F, 16); out = (float*)(F.ws + WS_KVMOD); col0 = cb * 256; }
    const float* c = in_ptr(F, 1);
    f32x4 acc = (f32x4){0.f, 0.f, 0.f, 0.f};
    const float* wp = W + (size_t)(F.wave * 256) * N + col0 + 4 * F.lane;
#pragma unroll 8
    for (int k = 0; k < 256; ++k) { const float cv = c[F.wave * 256 + k]; const float s = silu_f(cv); const f32x4 w = *(const GAS f32x4*)(wp + (size_t)k * N); acc += s * w; }
    LAS float* red = (LAS float*)F.lds;
    *(LAS f32x4*)(red + F.wave * 256 + 4 * F.lane) = acc;
    __syncthreads();
    if (F.tid < 256) { float s = bias[col0 + F.tid];
#pragma unroll
        for (int w = 0; w < 8; ++w) s += red[w * 256 + F.tid];
        out[col0 + F.tid] = s; }
    __syncthreads();
}
__device__ __forceinline__ void p0_posb_item(Frame& F, int i) {
    const float* pos = in_ptr(F, 18) + i * 4096; const float* W1 = in_ptr(F, 19) + (size_t)i * 4096 * 128;
    float a0 = 0.f, a1 = 0.f;
    for (int k = F.wave * 512; k < F.wave * 512 + 512; ++k) { const float p = pos[k]; a0 += p * W1[k * 128 + F.lane]; a1 += p * W1[k * 128 + 64 + F.lane]; }
    LAS float* red = (LAS float*)F.lds;
    red[F.wave * 128 + F.lane] = a0; red[F.wave * 128 + 64 + F.lane] = a1;
    __syncthreads();
    if (F.tid < 128) { float s = 0.f;
#pragma unroll
        for (int w = 0; w < 8; ++w) s += red[w * 128 + F.tid];
        ((float*)(F.ws + WS_POSB))[i * 128 + F.tid] = s; }
    __syncthreads();
}
__device__ __forceinline__ void p0_prologue(Frame& F) {
    for (int it = F.vcu; it < 210; it += F.G) { if (it < 208) p0_gemv_item(F, it); else p0_posb_item(F, it - 208); }
    { const float* ws_ = in_ptr(F, 11); bf16* o = (bf16*)(F.ws + WS_WSB);
      for (int i = F.vcu * 512 + F.tid; i < 2 * 16 * 128 * 128; i += F.G * 512) { const int s = i & 127, t = (i >> 7) & 127; o[i] = (s <= t) ? (bf16)f2bf(ws_[i]) : (bf16)0; } }
    LAS float* scr = (LAS float*)(F.lds + RING_OFF + F.wave * 16384);
    const int gw = F.vcu * NWAVES + F.wave, NGW = F.G * NWAVES;
    constexpr int I_SGIN = (D / 64) * (2 * SGW / 32), I_SGOUT = (SGW / 64) * (D / 32), I_UP = (D / 64) * (DFF2 / 32), I_DOWN = (DFF / 64) * (D / 32);
    constexpr int I_KV = (D / 64) * (NKVC / 32), I_Q = (D / 64) * (D / 32), I_O = I_Q;
    constexpr int NITEMS = 2 * I_SGIN + 2 * I_SGOUT + 4 * I_UP + 4 * I_DOWN + I_KV + 2 * I_Q + 2 * I_O;
    for (int it = gw; it < NITEMS; it += NGW) {
        int r = it;
        if (r < 2 * I_SGIN) { const int a = r / I_SGIN; r -= a * I_SGIN; p0_transpose_item(in_ptr(F, 9) + (size_t)a * D * 2 * SGW, 2 * SGW, D, 2 * SGW, (bf16*)(F.ws + WS_WT_SGIN) + (size_t)a * 2 * SGW * D, scr, r, F.lane); continue; } r -= 2 * I_SGIN;
        if (r < 2 * I_SGOUT) { const int a = r / I_SGOUT; r -= a * I_SGOUT; p0_transpose_item(in_ptr(F, 13) + (size_t)a * SGW * D, D, SGW, D, (bf16*)(F.ws + WS_WT_SGOUT) + (size_t)a * D * SGW, scr, r, F.lane); continue; } r -= 2 * I_SGOUT;
        if (r < 4 * I_UP) { const int a = r / I_UP; r -= a * I_UP; p0_transpose_item(in_ptr(F, 5) + (size_t)a * D * DFF2, DFF2, D, DFF2, (bf16*)(F.ws + WS_WT_UP) + (size_t)a * DFF2 * D, scr, r, F.lane); continue; } r -= 4 * I_UP;
        if (r < 4 * I_DOWN) { const int a = r / I_DOWN; r -= a * I_DOWN; p0_transpose_item(in_ptr(F, 8) + (size_t)a * DFF * D, D, DFF, D, (bf16*)(F.ws + WS_WT_DOWN) + (size_t)a * D * DFF, scr, r, F.lane); continue; } r -= 4 * I_DOWN;
        if (r < I_KV) { p0_transpose_item(in_ptr(F, 17), NKVC, D, NKVC, (bf16*)(F.ws + WS_WT_KV), scr, r, F.lane); continue; } r -= I_KV;
        if (r < 2 * I_Q) { const int a = r / I_Q; r -= a * I_Q; p0_transpose_item(in_ptr(F, 22) + (size_t)a * D * NQG, NQG, D, D, (bf16*)(F.ws + WS_WT_Q) + (size_t)a * D * D, scr, r, F.lane); continue; } r -= 2 * I_Q;
        { const int a = r / I_O; r -= a * I_O; p0_transpose_item(in_ptr(F, 24) + (size_t)a * D * D, D, D, D, (bf16*)(F.ws + WS_WT_O) + (size_t)a * D * D, scr, r, F.lane); }
    }
}

template <bool DUAL>
__device__ __forceinline__ void rowmod_phase(Frame& F, const float* x, const float* gain, const float* shift, const float* scale, bf16* out,
                                             const float* gain2, const float* shift2, const float* scale2, bf16* out2) {
    const int gw = F.vcu * NWAVES + F.wave, NGW = F.G * NWAVES;
    f32x4 ca[8], cb[8], ca2[8], cb2[8];
#pragma unroll
    for (int j = 0; j < 8; ++j) { const int c = 4 * F.lane + 256 * j;
        const f32x4 g = *(const GAS f32x4*)(gain + c), sc = *(const GAS f32x4*)(scale + c); ca[j] = g * (sc + 1.0f); cb[j] = *(const GAS f32x4*)(shift + c);
        if (DUAL) { const f32x4 g2 = *(const GAS f32x4*)(gain2 + c), sc2 = *(const GAS f32x4*)(scale2 + c); ca2[j] = g2 * (sc2 + 1.0f); cb2[j] = *(const GAS f32x4*)(shift2 + c); } }
    for (int m = gw; m < T; m += NGW) {
        const GAS f32x4* xr = (const GAS f32x4*)(x + (size_t)m * D) + F.lane;
        f32x4 v[8]; float s = 0.f;
#pragma unroll
        for (int j = 0; j < 8; ++j) { v[j] = xr[64 * j]; s += (v[j].x * v[j].x + v[j].y * v[j].y) + (v[j].z * v[j].z + v[j].w * v[j].w); }
        const float rstd = 1.0f / sqrtf(wave_sum(s) * (1.0f / D) + EPS);
        GAS v2u* o8 = (GAS v2u*)(out + (size_t)m * D) + F.lane;
#pragma unroll
        for (int j = 0; j < 8; ++j) { const f32x4 y = v[j] * rstd * ca[j] + cb[j]; v2u w; w.x = pk2(y.x, y.y); w.y = pk2(y.z, y.w); o8[64 * j] = w; }
        if (DUAL) { GAS v2u* p8 = (GAS v2u*)(out2 + (size_t)m * D) + F.lane;
#pragma unroll
            for (int j = 0; j < 8; ++j) { const f32x4 y = v[j] * rstd * ca2[j] + cb2[j]; v2u w; w.x = pk2(y.x, y.y); w.y = pk2(y.z, y.w); p8[64 * j] = w; } }
    }
}

__device__ __forceinline__ void colss_phase(Frame& F) {
    const bf16* VT = (const bf16*)(F.ws + WS_VT); float* SSP = (float*)(F.ws + WS_SSP);
    LAS float* red = (LAS float*)F.lds;
    for (int it = F.vcu; it < 512; it += F.G) {
        const int tb = it >> 5, cb = it & 31; const int t0 = tb * 512 + 8 * F.lane;
        float a[8];
#pragma unroll
        for (int e = 0; e < 8; ++e) a[e] = 0.f;
#pragma unroll 4
        for (int i = 0; i < 16; ++i) { const v4u v = *(const GAS v4u*)(VT + (size_t)(cb * 128 + F.wave * 16 + i) * T + t0);
            const unsigned w[4] = {v.x, v.y, v.z, v.w};
#pragma unroll
            for (int q = 0; q < 4; ++q) { const float lo = bflo(w[q]), hi = bfhi(w[q]); a[2 * q] += lo * lo; a[2 * q + 1] += hi * hi; } }
#pragma unroll
        for (int e = 0; e < 8; ++e) red[F.wave * 512 + 8 * F.lane + e] = a[e];
        __syncthreads();
        { float s = 0.f;
#pragma unroll
          for (int w = 0; w < 8; ++w) s += red[w * 512 + F.tid];
          SSP[(size_t)cb * T + tb * 512 + F.tid] = s; }
        __syncthreads();
    }
}
__device__ __forceinline__ void spatial_phase(Frame& F, int a) {
    const bf16* Wc = (const bf16*)(F.ws + WS_WSB) + (size_t)a * 16 * 128 * 128; const float* vgain = in_ptr(F, 10) + a * SGW; const float* bs = in_ptr(F, 12) + a * 16 * 128;
    const bf16* VT = (const bf16*)(F.ws + WS_VT); const bf16* U = (const bf16*)(F.ws + WS_U); bf16* US = (bf16*)(F.ws + WS_US); const float* SSP = (const float*)(F.ws + WS_SSP);
    LAS float* rsl = (LAS float*)F.lds;
    const int wr = F.wave >> 2, wc = F.wave & 3, fr = F.lane & 15, fq = F.lane >> 4;
    for (int unit = F.vcu; unit < 64 * 16; unit += F.G) {
        const int n = unit >> 4, g = unit & 15;
        __syncthreads();
        if (F.tid < 128) { float ss = 0.f;
#pragma unroll 8
            for (int cb = 0; cb < 32; ++cb) ss += SSP[(size_t)cb * T + n * 128 + F.tid];
            rsl[F.tid] = 1.0f / sqrtf(ss * (1.0f / SGW) + EPS); }
        __syncthreads();
        f32x4 acc[4][4];
#pragma unroll
        for (int mi = 0; mi < 4; ++mi)
#pragma unroll
            for (int ni = 0; ni < 4; ++ni) acc[mi][ni] = (f32x4){0.f, 0.f, 0.f, 0.f};
#pragma unroll
        for (int ks = 0; ks < 4; ++ks) {
            if (ks * 32 > wr * 64 + 63) continue;
            float rs[8];
#pragma unroll
            for (int j = 0; j < 8; ++j) rs[j] = rsl[ks * 32 + 8 * fq + j];
            bf16x8 af[4], bfr[4];
#pragma unroll
            for (int mi = 0; mi < 4; ++mi) { const v4u w = *(const GAS v4u*)(Wc + ((size_t)(g * 128 + wr * 64 + mi * 16 + fr) * 128 + ks * 32 + 8 * fq));
                v4u o; o.x = pk2(bflo(w.x) * rs[0], bfhi(w.x) * rs[1]); o.y = pk2(bflo(w.y) * rs[2], bfhi(w.y) * rs[3]); o.z = pk2(bflo(w.z) * rs[4], bfhi(w.z) * rs[5]); o.w = pk2(bflo(w.w) * rs[6], bfhi(w.w) * rs[7]);
                af[mi] = __builtin_bit_cast(bf16x8, o); }
#pragma unroll
            for (int ni = 0; ni < 4; ++ni) bfr[ni] = *(const GAS bf16x8*)(VT + (size_t)(g * 256 + wc * 64 + ni * 16 + fr) * T + n * 128 + ks * 32 + 8 * fq);
#pragma unroll
            for (int mi = 0; mi < 4; ++mi)
#pragma unroll
                for (int ni = 0; ni < 4; ++ni) acc[mi][ni] = __builtin_amdgcn_mfma_f32_16x16x32_bf16(bfr[ni], af[mi], acc[mi][ni], 0, 0, 0);
        }
#pragma unroll
        for (int mi = 0; mi < 4; ++mi) { const int t = wr * 64 + mi * 16 + fr; const float bt = bs[g * 128 + t]; const size_t ro = (size_t)(n * 128 + t) * SGW;
#pragma unroll
            for (int ni = 0; ni < 4; ++ni) { const int cc = g * 256 + wc * 64 + ni * 16 + 4 * fq;
                const v2u uu = *(const GAS v2u*)(U + ro + cc); const f32x4 gv = *(const GAS f32x4*)(vgain + cc); const f32x4 val = acc[mi][ni] * gv + bt;
                v2u o; o.x = pk2(bflo(uu.x) * val.x, bfhi(uu.x) * val.y); o.y = pk2(bflo(uu.y) * val.z, bfhi(uu.y) * val.w);
                *(GAS v2u*)(US + ro + cc) = o; } }
    }
}

__device__ __forceinline__ void convgate_phase(Frame& F, int layer) {
    const bf16* Z = (const bf16*)(F.ws + WS_Z); bf16* Gb = (bf16*)(F.ws + WS_G);
    const float* cw = in_ptr(F, 6) + (size_t)layer * 3 * DFF2; const float* cbv = in_ptr(F, 7) + (size_t)layer * DFF2;
    const int gw = F.vcu * NWAVES + F.wave, NGW = F.G * NWAVES;
    for (int it = gw; it < 11 * 256; it += NGW) {
        const int cc = it % 11, rc = it / 11; const int j0 = cc * 512 + 8 * F.lane, t0 = rc * 32;
        float wa[3][8], wv[3][8], ba[8], bv[8];
#pragma unroll
        for (int k = 0; k < 3; ++k)
#pragma unroll
            for (int e = 0; e < 8; ++e) { wa[k][e] = cw[k * DFF2 + j0 + e]; wv[k][e] = cw[k * DFF2 + DFF + j0 + e]; }
#pragma unroll
        for (int e = 0; e < 8; ++e) { ba[e] = cbv[j0 + e]; bv[e] = cbv[DFF + j0 + e]; }
        float a1[8], a2[8], v1[8], v2[8];
#pragma unroll
        for (int e = 0; e < 8; ++e) { a1[e] = 0.f; a2[e] = 0.f; v1[e] = 0.f; v2[e] = 0.f; }
        if (t0 > 0) {
            const v4u pa1 = *(const GAS v4u*)(Z + (size_t)(t0 - 1) * DFF2 + j0), pa2 = *(const GAS v4u*)(Z + (size_t)(t0 - 2) * DFF2 + j0);
            const v4u pv1 = *(const GAS v4u*)(Z + (size_t)(t0 - 1) * DFF2 + DFF + j0), pv2 = *(const GAS v4u*)(Z + (size_t)(t0 - 2) * DFF2 + DFF + j0);
            const unsigned xa1[4] = {pa1.x, pa1.y, pa1.z, pa1.w}, xa2[4] = {pa2.x, pa2.y, pa2.z, pa2.w}, xv1[4] = {pv1.x, pv1.y, pv1.z, pv1.w}, xv2[4] = {pv2.x, pv2.y, pv2.z, pv2.w};
#pragma unroll
            for (int q = 0; q < 4; ++q) { a1[2 * q] = bflo(xa1[q]); a1[2 * q + 1] = bfhi(xa1[q]); a2[2 * q] = bflo(xa2[q]); a2[2 * q + 1] = bfhi(xa2[q]);
                v1[2 * q] = bflo(xv1[q]); v1[2 * q + 1] = bfhi(xv1[q]); v2[2 * q] = bflo(xv2[q]); v2[2 * q + 1] = bfhi(xv2[q]); }
        }
#pragma unroll 2
        for (int t = t0; t < t0 + 32; ++t) {
            const v4u pa = *(const GAS v4u*)(Z + (size_t)t * DFF2 + j0), pv = *(const GAS v4u*)(Z + (size_t)t * DFF2 + DFF + j0);
            const unsigned xa[4] = {pa.x, pa.y, pa.z, pa.w}, xv[4] = {pv.x, pv.y, pv.z, pv.w};
            float a0[8], v0[8], o[8];
#pragma unroll
            for (int q = 0; q < 4; ++q) { a0[2 * q] = bflo(xa[q]); a0[2 * q + 1] = bfhi(xa[q]); v0[2 * q] = bflo(xv[q]); v0[2 * q + 1] = bfhi(xv[q]); }
#pragma unroll
            for (int e = 0; e < 8; ++e) { const float av = ba[e] + wa[0][e] * a2[e] + wa[1][e] * a1[e] + wa[2][e] * a0[e]; const float vv = bv[e] + wv[0][e] * v2[e] + wv[1][e] * v1[e] + wv[2][e] * v0[e];
                o[e] = silu_f(av) * vv; a2[e] = a1[e]; a1[e] = a0[e]; v2[e] = v1[e]; v1[e] = v0[e]; }
            v4u w; w.x = pk2(o[0], o[1]); w.y = pk2(o[2], o[3]); w.z = pk2(o[4], o[5]); w.w = pk2(o[6], o[7]);
            *(GAS v4u*)(Gb + (size_t)t * DFF + j0) = w;
        }
    }
}

constexpr int CMP_WSL = 8192 + 512;
__device__ __forceinline__ void kvpost_phase(Frame& F) {
    bf16* KV = (bf16*)(F.ws + WS_KV); const float* kg = in_ptr(F, 21);
    const int gw = F.vcu * NWAVES + F.wave, NGW = F.G * NWAVES;
    LAS unsigned char* wl = F.lds + F.wave * 16384;
    LAS bf16* al = (LAS bf16*)wl; LAS float* h1 = (LAS float*)(wl + 8192);
    const float* posb = (const float*)(F.ws + WS_POSB);
    if (gw == 0) {
#pragma unroll
        for (int q = 0; q < 2; ++q) { bf16* base = (bf16*)(F.ws + (q ? WS_VC : WS_KC));
            const int g = F.lane >> 4, ch = F.lane & 15; *(GAS v4u*)(base + (size_t)(g * 512 + 511) * HD + ch * 8) = (v4u){0u, 0u, 0u, 0u}; } }
    for (int it = gw; it < T + 2 * NCMP * 4; it += NGW) {
        if (it < T) {
            const int t = it;
#pragma unroll
            for (int q = 0; q < 2; ++q) { const int tensor = q ? 4 : 2; bf16* p = KV + (size_t)t * NKVC + tensor * 512 + 8 * F.lane;
                const v4u v = *(const GAS v4u*)p; const unsigned w[4] = {v.x, v.y, v.z, v.w}; float x[8]; float ss = 0.f;
#pragma unroll
                for (int e = 0; e < 4; ++e) { x[2 * e] = bflo(w[e]); x[2 * e + 1] = bfhi(w[e]); ss += x[2 * e] * x[2 * e] + x[2 * e + 1] * x[2 * e + 1]; }
                ss += __shfl_xor(ss, 1); ss += __shfl_xor(ss, 2); ss += __shfl_xor(ss, 4); ss += __shfl_xor(ss, 8);
                const float rs = 1.0f / sqrtf(ss * (1.0f / HD) + EPS); const float* gp = kg + (q ? 2 : 1) * HD + ((8 * F.lane) & 127);
                v4u o; o.x = pk2(x[0] * rs * gp[0], x[1] * rs * gp[1]); o.y = pk2(x[2] * rs * gp[2], x[3] * rs * gp[3]); o.z = pk2(x[4] * rs * gp[4], x[5] * rs * gp[5]); o.w = pk2(x[6] * rs * gp[6], x[7] * rs * gp[7]);
                *(GAS v4u*)p = o; }
        } else {
            int r = it - T; const int i = r / (NCMP * 4); r -= i * NCMP * 4; const int n = r >> 2, g = r & 3;
#pragma unroll
            for (int q = 0; q < 8; ++q) { const int idx = F.lane + 64 * q; const int l = idx >> 4, ch = idx & 15;
                const v4u v = *(const GAS v4u*)(KV + (size_t)(16 * n + l) * NKVC + i * 512 + g * 128 + 8 * ch);
                *(LAS v4u*)(al + l * 128 + 8 * ch) = v; }
            LDS_WAIT(); asm volatile("" ::: "memory");
            const float* W1 = in_ptr(F, 19) + (size_t)i * 4096 * 128; const float* W2 = in_ptr(F, 20) + (size_t)i * 128 * 128;
            float a0 = posb[i * 128 + F.lane], a1 = posb[i * 128 + 64 + F.lane];
#pragma unroll 4
            for (int k = 0; k < 4096; k += 2) { const unsigned w = *(const LAS unsigned*)(al + k); const float x0 = bflo(w), x1 = bfhi(w);
                a0 += x0 * W1[k * 128 + F.lane]; a1 += x0 * W1[k * 128 + 64 + F.lane];
                a0 += x1 * W1[(k + 1) * 128 + F.lane]; a1 += x1 * W1[(k + 1) * 128 + 64 + F.lane]; }
            h1[F.lane] = pg8::gelu_tanh(a0); h1[64 + F.lane] = pg8::gelu_tanh(a1);
            LDS_WAIT(); asm volatile("" ::: "memory");
            float o0 = 0.f, o1 = 0.f;
#pragma unroll 8
            for (int k = 0; k < 128; ++k) { const float x = h1[k]; o0 += x * W2[k * 128 + F.lane]; o1 += x * W2[k * 128 + 64 + F.lane]; }
            if (i == 0) { const float ss = wave_sum(o0 * o0 + o1 * o1); const float rs = 1.0f / sqrtf(ss * (1.0f / HD) + EPS); o0 *= rs * kg[F.lane]; o1 *= rs * kg[64 + F.lane]; }
            bf16* dst = (bf16*)(F.ws + (i ? WS_VC : WS_KC)) + (size_t)(g * 512 + n) * HD;
            dst[F.lane] = (bf16)f2bf(o0); dst[64 + F.lane] = (bf16)f2bf(o1);
            LDS_WAIT(); asm volatile("" ::: "memory");
        }
    }
}

__device__ __forceinline__ void gates_phase(Frame& F, int bl) {
    const bf16* H = (const bf16*)(F.ws + WS_H); float* GT = (float*)(F.ws + WS_GATES);
    const float* Wg = in_ptr(F, 22) + (size_t)bl * D * NQG + 2048;
    const int gw = F.vcu * NWAVES + F.wave, NGW = F.G * NWAVES;
    LAS bf16* hl = (LAS bf16*)(F.lds + F.wave * 16384);
    for (int it = gw; it < T / 4; it += NGW) {
        const int t0 = it * 4;
#pragma unroll
        for (int q = 0; q < 16; ++q) { const int idx = F.lane + 64 * q;
            *(LAS v4u*)(hl + idx * 8) = *(const GAS v4u*)(H + (size_t)t0 * D + idx * 8); }
        LDS_WAIT(); asm volatile("" ::: "memory");
        const int col = F.lane < 48 ? F.lane : 47;
        float a0 = 0.f, a1 = 0.f, a2 = 0.f, a3 = 0.f;
#pragma unroll 4
        for (int k = 0; k < D; k += 2) { const float w0 = Wg[(size_t)k * NQG + col], w1 = Wg[(size_t)(k + 1) * NQG + col];
            const unsigned h0 = *(const LAS unsigned*)(hl + k), h1_ = *(const LAS unsigned*)(hl + 2048 + k), h2 = *(const LAS unsigned*)(hl + 4096 + k), h3 = *(const LAS unsigned*)(hl + 6144 + k);
            a0 += bflo(h0) * w0 + bfhi(h0) * w1; a1 += bflo(h1_) * w0 + bfhi(h1_) * w1; a2 += bflo(h2) * w0 + bfhi(h2) * w1; a3 += bflo(h3) * w0 + bfhi(h3) * w1; }
        if (F.lane < 48) { GT[(size_t)(t0 + 0) * 48 + F.lane] = sigmoid_f(a0); GT[(size_t)(t0 + 1) * 48 + F.lane] = sigmoid_f(a1); GT[(size_t)(t0 + 2) * 48 + F.lane] = sigmoid_f(a2); GT[(size_t)(t0 + 3) * 48 + F.lane] = sigmoid_f(a3); }
        LDS_WAIT(); asm volatile("" ::: "memory");
    }
}

constexpr int AN_QS = 0, AN_SC = 2048, AN_RI = AN_SC + 8192, AN_IMP = AN_RI + 2048, AN_SEL = AN_IMP + 512, AN_WSL = 13312;
struct AttnState { float m[4], l[4], o[4][2]; };
template <class KeyMap>
__device__ __forceinline__ void attn_chunk(Frame& F, LAS unsigned char* wl, const bf16* Kb, const bf16* Vb, int rstride, int nk, const KeyMap& km, const float (&slope)[4], AttnState& st) {
    LAS float* qs = (LAS float*)(wl + AN_QS); LAS float* sc = (LAS float*)(wl + AN_SC); LAS int* ri = (LAS int*)(wl + AN_RI);
    const int lane = F.lane;
    for (int j = lane; j < nk; j += 64) {
        int row, dist; km(j, row, dist);
        ri[j] = row;
        float a[4] = {0.f, 0.f, 0.f, 0.f};
        if (dist >= 0) {
            const bf16* kp = Kb + (size_t)row * rstride;
#pragma unroll 4
            for (int c = 0; c < 16; ++c) { const v4u v = *(const GAS v4u*)(kp + 8 * c); const unsigned w[4] = {v.x, v.y, v.z, v.w}; float x[8];
#pragma unroll
                for (int e = 0; e < 4; ++e) { x[2 * e] = bflo(w[e]); x[2 * e + 1] = bfhi(w[e]); }
#pragma unroll
                for (int r = 0; r < 4; ++r) { const f32x4 q0 = *(const LAS f32x4*)(qs + r * 128 + 8 * c), q1 = *(const LAS f32x4*)(qs + r * 128 + 8 * c + 4);
                    a[r] += (x[0] * q0.x + x[1] * q0.y) + (x[2] * q0.z + x[3] * q0.w) + (x[4] * q1.x + x[5] * q1.y) + (x[6] * q1.z + x[7] * q1.w); } }
        }
#pragma unroll
        for (int r = 0; r < 4; ++r) sc[r * 512 + j] = dist >= 0 ? a[r] - slope[r] * (float)dist : NEGBIG;
    }
    LDS_WAIT(); asm volatile("" ::: "memory");
#pragma unroll
    for (int r = 0; r < 4; ++r) {
        float cm = NEGBIG;
        for (int j = lane; j < nk; j += 64) cm = fmaxf(cm, sc[r * 512 + j]);
        cm = wave_max(cm);
        const float mn = fmaxf(st.m[r], cm);
        const float alpha = __expf(st.m[r] - mn);
        float ps = 0.f;
        for (int j = lane; j < nk; j += 64) { const float s = sc[r * 512 + j]; const float p = s > -1e29f ? __expf(s - mn) : 0.f; sc[r * 512 + j] = p; ps += p; }
        ps = wave_sum(ps);
        st.l[r] = st.l[r] * alpha + ps; st.o[r][0] *= alpha; st.o[r][1] *= alpha; st.m[r] = mn;
    }
    LDS_WAIT(); asm volatile("" ::: "memory");
    for (int j = 0; j < nk; ++j) {
        const int row = ri[j];
        const unsigned vv = *(const GAS unsigned*)(Vb + (size_t)row * rstride + 2 * lane); const float v0 = bflo(vv), v1 = bfhi(vv);
#pragma unroll
        for (int r = 0; r < 4; ++r) { const float p = sc[r * 512 + j]; st.o[r][0] += p * v0; st.o[r][1] += p * v1; }
    }
    LDS_WAIT(); asm volatile("" ::: "memory");
}
struct KmCmp { int t; __device__ __forceinline__ void operator()(int j, int& row, int& dist) const { row = j; dist = t - (16 * j + 31); } };
struct KmSlc { int t; const LAS int* sel; int base; __device__ __forceinline__ void operator()(int j, int& row, int& dist) const { const int b = sel[base + (j >> 6)]; const int p = 64 * b + (j & 63); row = p; dist = t - p; } };
struct KmWin { int t; int p0; __device__ __forceinline__ void operator()(int j, int& row, int& dist) const { const int p = p0 + j; row = p; dist = t - p; } };

__device__ __forceinline__ void attn_naive_phase(Frame& F, int bl) {
    const bf16* Q = (const bf16*)(F.ws + WS_Q); const bf16* KV = (const bf16*)(F.ws + WS_KV); const bf16* KC = (const bf16*)(F.ws + WS_KC); const bf16* VC = (const bf16*)(F.ws + WS_VC);
    const float* GT = (const float*)(F.ws + WS_GATES); bf16* ATT = (bf16*)(F.ws + WS_ATT); const float* qg = in_ptr(F, 23) + bl * HD;
    const int gw = F.vcu * NWAVES + F.wave, NGW = F.G * NWAVES; const int lane = F.lane;
    LAS unsigned char* wl = F.lds + F.wave * AN_WSL;
    LAS float* qs = (LAS float*)(wl + AN_QS); LAS float* sc = (LAS float*)(wl + AN_SC); LAS float* imp = (LAS float*)(wl + AN_IMP); LAS int* sel = (LAS int*)(wl + AN_SEL);
    const float qscale = 0.08838834764831845f;
    for (int item = gw; item < T * 4; item += NGW) {
        const int t = item >> 2, g = item & 3;
        float slope[4];
#pragma unroll
        for (int r = 0; r < 4; ++r) {
            slope[r] = __builtin_amdgcn_exp2f(-0.5f * (float)(g * 4 + r + 1));
            const unsigned w = *(const GAS unsigned*)(Q + (size_t)t * D + (g * 4 + r) * HD + 2 * lane); const float q0 = bflo(w), q1 = bfhi(w);
            const float ss = wave_sum(q0 * q0 + q1 * q1); const float rs = 1.0f / sqrtf(ss * (1.0f / HD) + EPS) * qscale;
            qs[r * 128 + 2 * lane] = q0 * rs * qg[2 * lane]; qs[r * 128 + 2 * lane + 1] = q1 * rs * qg[2 * lane + 1]; }
        LDS_WAIT(); asm volatile("" ::: "memory");
        float outv[4][2];
        { int nv = t >= 31 ? ((t - 31) >> 4) + 1 : 0; if (nv > NCMP) nv = NCMP;
          AttnState st;
#pragma unroll
          for (int r = 0; r < 4; ++r) { st.m[r] = NEGBIG; st.l[r] = 0.f; st.o[r][0] = 0.f; st.o[r][1] = 0.f; }
          imp[lane] = 0.f; imp[64 + lane] = 0.f;
          if (nv > 0) {
              KmCmp km{t};
              attn_chunk(F, wl, KC + (size_t)g * 512 * HD, VC + (size_t)g * 512 * HD, HD, nv, km, slope, st);
              float inv[4];
#pragma unroll
              for (int r = 0; r < 4; ++r) inv[r] = 1.0f / fmaxf(st.l[r], 1e-30f);
#pragma unroll
              for (int h = 0; h < 2; ++h) { const int s = lane + 64 * h; float a = 0.f;
                  for (int n = 4 * s - 1; n <= 4 * s + 3; ++n) if (n >= 0 && n < nv) { a += sc[n] * inv[0] + sc[512 + n] * inv[1] + sc[1024 + n] * inv[2] + sc[1536 + n] * inv[3]; }
                  imp[s] = a; }
          }
          LDS_WAIT(); asm volatile("" ::: "memory");
#pragma unroll
          for (int r = 0; r < 4; ++r) { const float gt = GT[(size_t)t * 48 + 0 * 16 + g * 4 + r]; const float inv = 1.0f / fmaxf(st.l[r], 1e-30f); outv[r][0] = gt * st.o[r][0] * inv; outv[r][1] = gt * st.o[r][1] * inv; }
        }
        const int cur = t >> 6; int nsel;
        if (cur < 16) { nsel = cur + 1; if (lane < 16) sel[lane] = lane; }
        else {
            nsel = 16;
            float v0 = imp[lane], v1 = imp[64 + lane];
            { const int s0 = lane, s1 = lane + 64; if (s0 < 1 || s0 > cur - 2) v0 = -1.f; if (s1 > cur - 2) v1 = -1.f; }
            if (lane == 0) { sel[0] = 0; sel[1] = cur; sel[2] = cur - 1; }
            for (int k = 0; k < 13; ++k) {
                const float mx = wave_max(fmaxf(v0, v1));
                const unsigned long long b0 = __ballot(v0 == mx), b1 = __ballot(v1 == mx);
                const int idx = b0 ? (int)__builtin_ctzll(b0) : 64 + (int)__builtin_ctzll(b1);
                if (lane == 0) sel[3 + k] = idx;
                if (idx == lane) v0 = -1.f; if (idx == lane + 64) v1 = -1.f;
            }
        }
        LDS_WAIT(); asm volatile("" ::: "memory");
        { AttnState st;
#pragma unroll
          for (int r = 0; r < 4; ++r) { st.m[r] = NEGBIG; st.l[r] = 0.f; st.o[r][0] = 0.f; st.o[r][1] = 0.f; }
          for (int c0 = 0; c0 < nsel; c0 += 8) { const int nb = (nsel - c0) < 8 ? (nsel - c0) : 8; KmSlc km{t, sel, c0};
              attn_chunk(F, wl, KV + 2 * 512 + g * HD, KV + 3 * 512 + g * HD, NKVC, nb * 64, km, slope, st); }
#pragma unroll
          for (int r = 0; r < 4; ++r) { const float gt = GT[(size_t)t * 48 + 1 * 16 + g * 4 + r]; const float inv = 1.0f / fmaxf(st.l[r], 1e-30f); outv[r][0] += gt * st.o[r][0] * inv; outv[r][1] += gt * st.o[r][1] * inv; }
        }
        { AttnState st;
#pragma unroll
          for (int r = 0; r < 4; ++r) { st.m[r] = NEGBIG; st.l[r] = 0.f; st.o[r][0] = 0.f; st.o[r][1] = 0.f; }
          const int p0 = t - (WIN - 1) > 0 ? t - (WIN - 1) : 0; KmWin km{t, p0};
          attn_chunk(F, wl, KV + 4 * 512 + g * HD, KV + 5 * 512 + g * HD, NKVC, t - p0 + 1, km, slope, st);
#pragma unroll
          for (int r = 0; r < 4; ++r) { const float gt = GT[(size_t)t * 48 + 2 * 16 + g * 4 + r]; const float inv = 1.0f / fmaxf(st.l[r], 1e-30f); outv[r][0] += gt * st.o[r][0] * inv; outv[r][1] += gt * st.o[r][1] * inv; }
        }
#pragma unroll
        for (int r = 0; r < 4; ++r) *(GAS unsigned*)(ATT + (size_t)t * D + (g * 4 + r) * HD + 2 * lane) = pk2(outv[r][0], outv[r][1]);
    }
}

namespace att {
typedef short s16x4 __attribute__((ext_vector_type(4)));
typedef float f32x16 __attribute__((ext_vector_type(16)));
typedef unsigned u32x4 __attribute__((ext_vector_type(4)));
constexpr int SHM_K = 16384, SHM_V = 16384;
constexpr int L_K = 0, L_V = 32768, L_IMP = 65536, IMP_STRIDE = 132, L_WS = L_IMP + 8 * 8 * IMP_STRIDE * 4, L_UN = L_WS + 8 * 256, L_END = L_UN + 128;
static_assert(L_END <= RING_BYTES, "attention LDS");
constexpr float THR = 8.0f;
#define KSWZ(row, colB) ((row) * 256 + ((colB) ^ (((row) & 7) << 4)))
#define SBAR() __builtin_amdgcn_sched_barrier(0)
__device__ __forceinline__ int v_st(int k, int c) { const int kk = (k & ~0xC) | ((k & 4) << 1) | ((k & 8) >> 1); return ((kk >> 3) * 4 + (c >> 5)) * 512 + ((kk & 7) * 32 + (c & 31)) * 2; }
__device__ __forceinline__ int v_rd_base(int lane) { return ((lane & 3) << 3) | (((lane >> 2) & 3) << 6) | (((lane >> 4) & 1) << 5) | (((lane >> 5) & 1) << 8); }
constexpr int v_rd_off(int d0, int ks, int half) { return d0 * 512 + ks * 4096 + half * 2048; }
__device__ __forceinline__ int crow(int r, int hi) { return (r & 3) + 8 * (r >> 2) + 4 * hi; }
__device__ __forceinline__ unsigned cvtpk(float lo, float hi) { unsigned r; asm volatile("v_cvt_pk_bf16_f32 %0, %1, %2" : "=v"(r) : "v"(lo), "v"(hi)); return r; }

template <int STRIDE, bool MASKED>
__device__ __forceinline__ void init_p(f32x16& p0, f32x16& p1, float nb, float slope2, int dq, unsigned W) {
    const float NEG = -__builtin_inff();
#pragma unroll
    for (int r = 0; r < 16; ++r) {
        const int c = ((r & 3) + 8 * (r >> 2)) * STRIDE;
        float v0 = fmaf(slope2, (float)c, nb), v1 = fmaf(slope2, (float)(c + 32 * STRIDE), nb);
        if (MASKED) { if ((unsigned)(dq - c) >= W) v0 = NEG; if ((unsigned)(dq - c - 32 * STRIDE) >= W) v1 = NEG; }
        p0[r] = v0; p1[r] = v1;
    }
}
__device__ __forceinline__ void qkt(f32x16& p0, f32x16& p1, const LAS unsigned char* kt, int r32, int hi, const bf16x8 (&qr)[8]) {
    const LAS unsigned char* kb[4];
#pragma unroll
    for (int dd = 0; dd < 4; ++dd) kb[dd] = kt + KSWZ(r32, (dd * 16 + hi * 8) * 2);
#pragma unroll
    for (int d0 = 0; d0 < 8; ++d0) { const LAS unsigned char* a = kb[d0 & 3] + (d0 >> 2) * 128;
        const bf16x8 b0 = *(const LAS bf16x8*)a;
        const bf16x8 b1 = *(const LAS bf16x8*)(a + 32 * 256);
        p0 = __builtin_amdgcn_mfma_f32_32x32x16_bf16(b0, qr[d0], p0, 0, 0, 0);
        p1 = __builtin_amdgcn_mfma_f32_32x32x16_bf16(b1, qr[d0], p1, 0, 0, 0); if (d0 & 1) SBAR(); }
}
__device__ __forceinline__ void pv_tile(f32x16 (&o)[4], int vb, bf16x8 pa0, bf16x8 pa1, bf16x8 pa2, bf16x8 pa3) {
#define TRRD(dst, off) asm volatile("ds_read_b64_tr_b16 %0, %1 offset:%2" : "=&v"(dst) : "v"(vb), "i"(off) : "memory")
#define PV_D0(d0) do { { s16x4 l0, l1, h0, h1; constexpr int b_ = v_rd_off(d0, 0, 0); \
        TRRD(l0, b_); TRRD(h0, b_ + 2048); TRRD(l1, b_ + 4096); TRRD(h1, b_ + 6144); \
        asm volatile("s_waitcnt lgkmcnt(0)" ::: "memory"); SBAR(); \
        o[d0] = __builtin_amdgcn_mfma_f32_32x32x16_bf16(pa0, (bf16x8){l0[0], l0[1], l0[2], l0[3], h0[0], h0[1], h0[2], h0[3]}, o[d0], 0, 0, 0); \
        o[d0] = __builtin_amdgcn_mfma_f32_32x32x16_bf16(pa1, (bf16x8){l1[0], l1[1], l1[2], l1[3], h1[0], h1[1], h1[2], h1[3]}, o[d0], 0, 0, 0); } \
      { s16x4 l2, l3, h2, h3; constexpr int b_ = v_rd_off(d0, 0, 0); \
        TRRD(l2, b_ + 8192); TRRD(h2, b_ + 10240); TRRD(l3, b_ + 12288); TRRD(h3, b_ + 14336); \
        asm volatile("s_waitcnt lgkmcnt(0)" ::: "memory"); SBAR(); \
        o[d0] = __builtin_amdgcn_mfma_f32_32x32x16_bf16(pa2, (bf16x8){l2[0], l2[1], l2[2], l2[3], h2[0], h2[1], h2[2], h2[3]}, o[d0], 0, 0, 0); \
        o[d0] = __builtin_amdgcn_mfma_f32_32x32x16_bf16(pa3, (bf16x8){l3[0], l3[1], l3[2], l3[3], h3[0], h3[1], h3[2], h3[3]}, o[d0], 0, 0, 0); } } while (0)
    PV_D0(0); PV_D0(1); PV_D0(2); PV_D0(3);
#undef PV_D0
#undef TRRD
}
__device__ __forceinline__ float swap_max(float v) { auto rr = __builtin_amdgcn_permlane32_swap(__float_as_uint(v), __float_as_uint(v), false, false); return fmaxf(__uint_as_float(rr[0]), __uint_as_float(rr[1])); }
__device__ __forceinline__ float swap_sum(float v) { auto rr = __builtin_amdgcn_permlane32_swap(__float_as_uint(v), __float_as_uint(v), false, false); return __uint_as_float(rr[0]) + __uint_as_float(rr[1]); }
__device__ __forceinline__ float softmax_tile(f32x16& p0, f32x16& p1, float& m_reg, float& l_reg, bf16x8& pa0, bf16x8& pa1, bf16x8& pa2, bf16x8& pa3) {
    float pmax = p0[0];
#pragma unroll
    for (int r = 1; r < 16; ++r) pmax = fmaxf(pmax, p0[r]);
#pragma unroll
    for (int r = 0; r < 16; ++r) pmax = fmaxf(pmax, p1[r]);
    pmax = swap_max(pmax);
    float mn, alpha;
    if (__all((pmax - m_reg) <= THR)) { mn = m_reg; alpha = 1.f; }
    else { mn = fmaxf(m_reg, pmax); alpha = __builtin_amdgcn_exp2f(m_reg - mn); m_reg = mn; }
#pragma unroll
    for (int r = 0; r < 16; ++r) { p0[r] = __builtin_amdgcn_exp2f(p0[r] - mn); p1[r] = __builtin_amdgcn_exp2f(p1[r] - mn); }
    float ps = 0.f;
#pragma unroll
    for (int r = 0; r < 16; ++r) ps += p0[r] + p1[r];
    ps = swap_sum(ps);
    l_reg = l_reg * alpha + ps;
#define PK4(P, B_, OUT) do { unsigned a0 = cvtpk(P[B_+0], P[B_+1]), a1 = cvtpk(P[B_+2], P[B_+3]); \
        unsigned b0 = cvtpk(P[B_+4], P[B_+5]), b1 = cvtpk(P[B_+6], P[B_+7]); \
        auto r0 = __builtin_amdgcn_permlane32_swap(a0, b0, false, false); auto r1 = __builtin_amdgcn_permlane32_swap(a1, b1, false, false); \
        u32x4 w = {r0[0], r1[0], r0[1], r1[1]}; OUT = __builtin_bit_cast(bf16x8, w); } while (0)
    PK4(p0, 0, pa0); PK4(p0, 8, pa1); PK4(p1, 0, pa2); PK4(p1, 8, pa3);
#undef PK4
    return alpha;
}
__device__ __forceinline__ int next_bit(unsigned long long u0, unsigned long long u1, int from) {
    if (from < 64) { const unsigned long long m = u0 & (~0ull << from); if (m) return (int)__builtin_ctzll(m); from = 64; }
    if (from < 128) { const unsigned long long m = u1 & (~0ull << (from - 64)); if (m) return 64 + (int)__builtin_ctzll(m); }
    return 128;
}
__device__ __forceinline__ bool bit128(unsigned long long u0, unsigned long long u1, int s) { return s < 64 ? ((u0 >> s) & 1ull) != 0 : ((u1 >> (s - 64)) & 1ull) != 0; }
}

__device__ __forceinline__ void attn_unit(Frame& F, int bl, int qb, int g) {
    using namespace att;
    const bf16* Q = (const bf16*)(F.ws + WS_Q); const bf16* KV = (const bf16*)(F.ws + WS_KV); const bf16* KC = (const bf16*)(F.ws + WS_KC) + (size_t)g * 512 * HD; const bf16* VC = (const bf16*)(F.ws + WS_VC) + (size_t)g * 512 * HD;
    const float* GT = (const float*)(F.ws + WS_GATES); bf16* ATT = (bf16*)(F.ws + WS_ATT); const float* qg = in_ptr(F, 23) + bl * HD;
    int tid_ = F.tid; asm volatile("" : "+v"(tid_));
    const int tid = tid_, wid = F.wave, lane = tid & 63, r32 = lane & 31, hi = lane >> 5;
    LAS unsigned char* lds = F.lds;
    const int head = g * 4 + (r32 >> 3), qi = r32 & 7;
    const int t0 = qb * 64, t = t0 + wid * 8 + qi, cur = qb;
    const float slope2 = 1.4426950408889634f * __builtin_amdgcn_exp2f(-0.5f * (float)(head + 1));
    const int sr = tid >> 4, sc = (tid & 15) * 8; const int kws = KSWZ(sr, sc * 2), vst0 = v_st(sr, sc), vst1 = v_st(32 + sr, sc);
    const int vrb = (int)(unsigned)(size_t)(lds + L_V) + v_rd_base(lane);
    LAS float* wsf = (LAS float*)(lds + L_WS + wid * 256);
    LAS float* imp = (LAS float*)(lds + L_IMP) + wid * 8 * IMP_STRIDE;
    bf16x8 qr[8];
    { const bf16* qp = Q + (size_t)t * D + head * HD + hi * 8; float ss = 0.f;
#pragma unroll
      for (int d0 = 0; d0 < 8; ++d0) { qr[d0] = *(const GAS bf16x8*)(qp + d0 * 16); const v4u v = __builtin_bit_cast(v4u, qr[d0]); const unsigned w[4] = {v.x, v.y, v.z, v.w};
#pragma unroll
          for (int e = 0; e < 4; ++e) { const float a_ = bflo(w[e]), b_ = bfhi(w[e]); ss += a_ * a_ + b_ * b_; } }
      ss = swap_sum(ss);
      const float rs = (1.0f / sqrtf(ss * (1.0f / HD) + EPS)) * (0.08838834764831845f * 1.4426950408889634f);
#pragma unroll
      for (int d0 = 0; d0 < 8; ++d0) { const f32x4 g0 = *(const GAS f32x4*)(qg + d0 * 16 + hi * 8), g1 = *(const GAS f32x4*)(qg + d0 * 16 + hi * 8 + 4);
          const v4u v = __builtin_bit_cast(v4u, qr[d0]);
          u32x4 w; w.x = cvtpk(bflo(v.x) * rs * g0.x, bfhi(v.x) * rs * g0.y); w.y = cvtpk(bflo(v.y) * rs * g0.z, bfhi(v.y) * rs * g0.w);
          w.z = cvtpk(bflo(v.z) * rs * g1.x, bfhi(v.z) * rs * g1.y); w.w = cvtpk(bflo(v.w) * rs * g1.z, bfhi(v.w) * rs * g1.w);
          qr[d0] = __builtin_bit_cast(bf16x8, w); if (d0 & 1) SBAR(); } }
    unsigned oacc[4][8];
#pragma unroll
    for (int d0 = 0; d0 < 4; ++d0)
#pragma unroll
        for (int i = 0; i < 8; ++i) oacc[d0][i] = 0u;
    f32x16 o[4]; float m_reg, l_reg;
    bf16x8 st_k0, st_k1, st_v0, st_v1;
#define ST_LOAD(Kp, Vp, rowbase, rstride) do { const size_t o0_ = (size_t)((rowbase) + sr) * (rstride) + sc, o1_ = (size_t)((rowbase) + 32 + sr) * (rstride) + sc; \
        st_k0 = *(const GAS bf16x8*)((Kp) + o0_); st_k1 = *(const GAS bf16x8*)((Kp) + o1_); st_v0 = *(const GAS bf16x8*)((Vp) + o0_); st_v1 = *(const GAS bf16x8*)((Vp) + o1_); } while (0)
#define ST_WRITE(buf) do { *(LAS bf16x8*)(lds + L_K + (buf) * SHM_K + kws) = st_k0; *(LAS bf16x8*)(lds + L_K + (buf) * SHM_K + kws + 32 * 256) = st_k1; \
        *(LAS bf16x8*)(lds + L_V + (buf) * SHM_V + vst0) = st_v0; *(LAS bf16x8*)(lds + L_V + (buf) * SHM_V + vst1) = st_v1; } while (0)
#define BR_RESET() do { m_reg = -1e30f; l_reg = 0.f; _Pragma("unroll") for (int d_ = 0; d_ < 4; ++d_) _Pragma("unroll") for (int r_ = 0; r_ < 16; ++r_) o[d_][r_] = 0.f; } while (0)
#define RESC(a) do { if (__any((a) < 1.f)) { if (hi == 0) wsf[r32] = (a); asm volatile("s_waitcnt lgkmcnt(0)" ::: "memory"); \
        _Pragma("unroll") for (int r_ = 0; r_ < 16; ++r_) { const float al_ = wsf[crow(r_, hi)]; _Pragma("unroll") for (int d_ = 0; d_ < 4; ++d_) o[d_][r_] *= al_; } } } while (0)
#define TILE_COMPUTE(buf, STRIDE, masked, nb, dq, W) do { f32x16 p0, p1; \
        if (masked) init_p<STRIDE, true>(p0, p1, nb, slope2, dq, W); else init_p<STRIDE, false>(p0, p1, nb, slope2, dq, W); \
        qkt(p0, p1, lds + L_K + (buf) * SHM_K, r32, hi, qr); \
        bf16x8 pa0, pa1, pa2, pa3; const float al = softmax_tile(p0, p1, m_reg, l_reg, pa0, pa1, pa2, pa3); RESC(al); \
        pv_tile(o, vrb + (buf) * SHM_V, pa0, pa1, pa2, pa3); } while (0)
#define BR_FOLD(gidx) do { if (hi == 0) wsf[r32] = GT[(size_t)t * 48 + (gidx) * 16 + head] / fmaxf(l_reg, 1e-30f); asm volatile("s_waitcnt lgkmcnt(0)" ::: "memory"); \
        _Pragma("unroll") for (int i_ = 0; i_ < 8; ++i_) { const float f0_ = wsf[crow(2 * i_, hi)], f1_ = wsf[crow(2 * i_ + 1, hi)]; \
            _Pragma("unroll") for (int d_ = 0; d_ < 4; ++d_) { const unsigned w_ = oacc[d_][i_]; oacc[d_][i_] = cvtpk(bflo(w_) + o[d_][2 * i_] * f0_, bfhi(w_) + o[d_][2 * i_ + 1] * f1_); } } } while (0)

    const int NTc = (4 * qb + 3 + 63) >> 6;
    BR_RESET();
    { ST_LOAD(KC, VC, 0, HD); ST_WRITE(0); }
    __syncthreads();
    for (int j = 0; j < NTc; ++j) {
        const int buf = j & 1;
        if (j + 1 < NTc) ST_LOAD(KC, VC, (j + 1) * 64, HD);
        { const int dq = t - (16 * 64 * j + 31) - 64 * hi; const float nb = -slope2 * (float)dq;
          TILE_COMPUTE(buf, 16, true, nb, dq, 0x80000000u); }
        if (j + 1 < NTc) ST_WRITE(buf ^ 1);
        __syncthreads();
    }
    BR_FOLD(0);
    {
#pragma unroll
        for (int i = 0; i < 17; ++i) { const int idx = lane + 64 * i; if (idx < 8 * IMP_STRIDE) imp[idx] = 0.f; }
        const float invl = 1.0f / fmaxf(l_reg, 1e-30f);
        { ST_LOAD(KC, VC, 0, HD); ST_WRITE(0); }
        __syncthreads();
        for (int j = 0; j < NTc; ++j) {
            const int buf = j & 1;
            if (j + 1 < NTc) ST_LOAD(KC, VC, (j + 1) * 64, HD);
            { f32x16 p0, p1; const int dq = t - (16 * 64 * j + 31) - 64 * hi; const float nb = -slope2 * (float)dq;
              init_p<16, true>(p0, p1, nb, slope2, dq, 0x80000000u);
              qkt(p0, p1, lds + L_K + buf * SHM_K, r32, hi, qr);
#pragma unroll
              for (int hf = 0; hf < 2; ++hf)
#pragma unroll
                  for (int a = 0; a < 4; ++a) {
                      float e0, e1, e2, e3;
                      if (hf == 0) { e0 = p0[4 * a]; e1 = p0[4 * a + 1]; e2 = p0[4 * a + 2]; e3 = p0[4 * a + 3]; } else { e0 = p1[4 * a]; e1 = p1[4 * a + 1]; e2 = p1[4 * a + 2]; e3 = p1[4 * a + 3]; }
                      e0 = __builtin_amdgcn_exp2f(e0 - m_reg) * invl; e1 = __builtin_amdgcn_exp2f(e1 - m_reg) * invl; e2 = __builtin_amdgcn_exp2f(e2 - m_reg) * invl; e3 = __builtin_amdgcn_exp2f(e3 - m_reg) * invl;
                      float quad = (e0 + e1) + (e2 + e3), last = e3;
                      quad += __shfl_xor(quad, 8); quad += __shfl_xor(quad, 16); last += __shfl_xor(last, 8); last += __shfl_xor(last, 16);
                      const int s = 16 * j + 8 * hf + 2 * a + hi;
                      if (r32 < 8) { __hip_atomic_fetch_add(imp + qi * IMP_STRIDE + s, quad, __ATOMIC_RELAXED, __HIP_MEMORY_SCOPE_WORKGROUP);
                                     __hip_atomic_fetch_add(imp + qi * IMP_STRIDE + s + 1, last, __ATOMIC_RELAXED, __HIP_MEMORY_SCOPE_WORKGROUP); }
                  }
            }
            if (j + 1 < NTc) ST_WRITE(buf ^ 1);
            __syncthreads();
        }
    }
    unsigned long long wun0 = 0ull, wun1 = 0ull; LAS unsigned* wsel = (LAS unsigned*)(wsf + 32);
    asm volatile("s_waitcnt lgkmcnt(0)" ::: "memory");
    for (int q = 0; q < 8; ++q) {
        unsigned long long b0, b1;
        if (cur < 16) { b0 = (1ull << (cur + 1)) - 1ull; b1 = 0ull; }
        else {
            float v0 = imp[q * IMP_STRIDE + lane], v1 = imp[q * IMP_STRIDE + 64 + lane];
            if (lane < 1 || lane > cur - 2) v0 = -1.f;
            if (lane + 64 > cur - 2) v1 = -1.f;
            bool f0 = false, f1 = false;
            for (int k = 0; k < 13; ++k) {
                const float mx = wave_max(fmaxf(v0, v1));
                const unsigned long long e0 = __ballot(v0 == mx), e1 = __ballot(v1 == mx);
                const int idx = e0 ? (int)__builtin_ctzll(e0) : 64 + (int)__builtin_ctzll(e1);
                if (idx == lane) { v0 = -1.f; f0 = true; }
                if (idx == lane + 64) { v1 = -1.f; f1 = true; }
            }
            b0 = __ballot(f0) | 1ull; b1 = __ballot(f1);
            if (cur < 64) b0 |= 1ull << cur; else b1 |= 1ull << (cur - 64);
            if (cur - 1 < 64) b0 |= 1ull << (cur - 1); else b1 |= 1ull << (cur - 1 - 64);
        }
        if (lane == 0) { wsel[q * 4 + 0] = (unsigned)b0; wsel[q * 4 + 1] = (unsigned)(b0 >> 32); wsel[q * 4 + 2] = (unsigned)b1; wsel[q * 4 + 3] = (unsigned)(b1 >> 32); }
        wun0 |= b0; wun1 |= b1;
    }
    { LAS unsigned long long* un = (LAS unsigned long long*)(lds + L_UN);
      if (lane == 0) { un[wid * 2] = wun0; un[wid * 2 + 1] = wun1; }
      __syncthreads(); }
    unsigned long long u0 = 0ull, u1 = 0ull;
    { const LAS unsigned* un = (const LAS unsigned*)(lds + L_UN);
#pragma unroll
      for (int w = 0; w < 8; ++w) { const unsigned a0 = __builtin_amdgcn_readfirstlane(un[w * 4]), a1 = __builtin_amdgcn_readfirstlane(un[w * 4 + 1]), a2 = __builtin_amdgcn_readfirstlane(un[w * 4 + 2]), a3 = __builtin_amdgcn_readfirstlane(un[w * 4 + 3]);
          u0 |= ((unsigned long long)a1 << 32) | a0; u1 |= ((unsigned long long)a3 << 32) | a2; } }
    { const unsigned x0 = __builtin_amdgcn_readfirstlane((unsigned)wun0), x1 = __builtin_amdgcn_readfirstlane((unsigned)(wun0 >> 32)), x2 = __builtin_amdgcn_readfirstlane((unsigned)wun1), x3 = __builtin_amdgcn_readfirstlane((unsigned)(wun1 >> 32));
      wun0 = ((unsigned long long)x1 << 32) | x0; wun1 = ((unsigned long long)x3 << 32) | x2; }
    {
        const bf16* Kp = KV + 2 * 512 + g * HD; const bf16* Vp = KV + 3 * 512 + g * HD;
        BR_RESET();
        int s = next_bit(u0, u1, 0);
        { ST_LOAD(Kp, Vp, s * 64, NKVC); ST_WRITE(0); }
        __syncthreads();
        int buf = 0;
        while (s < 128) {
            const int sn = next_bit(u0, u1, s + 1);
            if (sn < 128) ST_LOAD(Kp, Vp, sn * 64, NKVC);
            if (bit128(wun0, wun1, s)) {
                const bool rowsel = ((wsel[qi * 4 + (s >> 5)] >> (s & 31)) & 1u) != 0u;
                const int dq = t - 64 * s - 4 * hi; const float nb = rowsel ? -slope2 * (float)dq : -__builtin_inff();
                const bool masked = (s == cur);
                TILE_COMPUTE(buf, 1, masked, nb, dq, 0x80000000u);
            }
            if (sn < 128) ST_WRITE(buf ^ 1);
            __syncthreads();
            buf ^= 1; s = sn;
        }
        BR_FOLD(1);
    }
    {
        const bf16* Kp = KV + 4 * 512 + g * HD; const bf16* Vp = KV + 5 * 512 + g * HD;
        BR_RESET();
        const int s_lo = cur - 8 > 0 ? cur - 8 : 0;
        { ST_LOAD(Kp, Vp, s_lo * 64, NKVC); ST_WRITE(0); }
        __syncthreads();
        int buf = 0;
        for (int s = s_lo; s <= cur; ++s) {
            if (s < cur) ST_LOAD(Kp, Vp, (s + 1) * 64, NKVC);
            { const int dq = t - 64 * s - 4 * hi; const float nb = -slope2 * (float)dq;
              const bool masked = (s == cur) || (s == cur - 8);
              TILE_COMPUTE(buf, 1, masked, nb, dq, (unsigned)WIN); }
            if (s < cur) ST_WRITE(buf ^ 1);
            __syncthreads();
            buf ^= 1;
        }
        BR_FOLD(2);
    }
    {
        LAS bf16* ot = (LAS bf16*)(lds + wid * 8192);
#pragma unroll
        for (int d0 = 0; d0 < 4; ++d0)
#pragma unroll
            for (int i = 0; i < 8; ++i) { const unsigned w = oacc[d0][i]; const int q0 = crow(2 * i, hi);
                ot[q0 * 128 + d0 * 32 + r32] = (bf16)(w & 0xffffu); ot[(q0 + 1) * 128 + d0 * 32 + r32] = (bf16)(w >> 16); }
        asm volatile("s_waitcnt lgkmcnt(0)" ::: "memory");
        int lane2 = lane; asm volatile("" : "+v"(lane2));
#pragma unroll
        for (int i = 0; i < 8; ++i) { const int idx = lane2 + 64 * i; const int q = idx >> 4, ch = idx & 15;
            const v4u v = *(const LAS v4u*)(ot + q * 128 + ch * 8);
            const int tt = t0 + wid * 8 + (q & 7), hh = g * 4 + (q >> 3);
            *(GAS v4u*)(ATT + (size_t)tt * D + hh * HD + ch * 8) = v; }
        __syncthreads();
    }
#undef ST_LOAD
#undef ST_WRITE
#undef BR_RESET
#undef RESC
#undef TILE_COMPUTE
#undef BR_FOLD
}
__device__ __forceinline__ void attn_phase(Frame& F, int bl) {
    for (int u = F.vcu; u < 256; u += F.G) {
        const int g = u & 3, qa = u >> 2;
        for (int h = 0; h < 2; ++h) attn_unit(F, bl, h ? 127 - qa : qa, g);
    }
}

struct Args { const float* in[25]; float* out; unsigned char* ws; int ph_lo, ph_hi; };
constexpr int NPHASES = 37;
__global__ void __launch_bounds__(NWAVES * 64, 2) yoco_fwd(Args args) {
    extern __shared__ __attribute__((aligned(16))) unsigned char lds[];
    Frame F;
    F.lds = (LAS unsigned char*)lds;
    F.MISC = (volatile LAS unsigned*)(F.lds + MISC_OFF);
    F.tid = threadIdx.x; F.lane = F.tid & 63; F.wave = __builtin_amdgcn_readfirstlane(F.tid >> 6);
    F.G = gridDim.x; { const int bx = blockIdx.x; F.vcu = (F.G % 8 == 0) ? (bx % 8) * (F.G / 8) + bx / 8 : bx; }
    F.ws = args.ws; F.ctl = (gu32*)(args.ws + WS_CTL); F.out = args.out;
    for (int u = F.tid; u < (LDS_BYTES - LDSCTL_OFF) / 4; u += NWAVES * 64) ((LAS unsigned*)(F.lds + LDSCTL_OFF))[u] = 0u;
    __syncthreads();
    if (F.tid < 25) { const unsigned long long pv = (unsigned long long)args.in[F.tid]; volatile LAS unsigned* p = (volatile LAS unsigned*)(F.lds + LDSCTL_OFF) + 2 * F.tid; p[0] = (unsigned)pv; p[1] = (unsigned)(pv >> 32); }
    __syncthreads();
    const int lo = args.ph_lo, hi = args.ph_hi;
    XcdBarrier bar; bar.bar = (unsigned*)(F.ctl + CW_BAR); bar.x = 0; bar.st = nullptr;
    if (hi - lo > 1) bar = xcd_barrier_post((unsigned*)(F.ctl + CW_BAR), F.MISC + 8);
    int pc = 0;
#define PH_BEGIN if (lo <= pc && pc < hi) { unsigned char* ws = F.ws; asm volatile("" : "+s"(ws)); \
    { int t_ = threadIdx.x; asm volatile("" : "+v"(t_)); F.tid = t_; F.lane = t_ & 63; F.wave = __builtin_amdgcn_readfirstlane(t_ >> 6); }
#define PH_END } { const bool both_ = (lo <= pc && pc + 1 < hi); ++pc; if (both_) xcd_barrier(bar); }
#define P_HB ((bf16*)(ws + WS_H))
#define P_HKV ((bf16*)(ws + WS_HKV))
#define P_XA ((float*)(ws + WS_XA))
#define P_XB ((float*)(ws + WS_XB))
#define P_MODS ((const float*)(ws + WS_MODS) + (size_t)layer * NMOD)
#define P_NG (in_ptr(F, 4) + (size_t)layer * 2 * D)
#define P_XIN (layer == 0 ? in_ptr(F, 0) : (const float*)P_XB)
#define P_XOUT (layer == DEPTH - 1 ? F.out : P_XB)
#define P_RING (F.lds + RING_OFF)
#define GEMM_CALL(EPI, g, S, E) pg8::gemm_phase<EPI, pg8::StaticOrder, PG8_ALIGN, PG8_SP2>(P_RING, g, S, E, F.tid)

    PH_BEGIN p0_prologue(F); PH_END

    for (int layer = 0; layer < DEPTH; ++layer) {
        PH_BEGIN
            const float* mods = P_MODS;
            if (layer == NA) { const float* kvm = (const float*)(ws + WS_KVMOD); rowmod_phase<true>(F, P_XIN, P_NG, mods, mods + D, P_HB, in_ptr(F, 14), kvm, kvm + D, P_HKV); }
            else rowmod_phase<false>(F, P_XIN, P_NG, mods, mods + D, P_HB, nullptr, nullptr, nullptr, nullptr);
        PH_END
        if (layer < NA) {
            PH_BEGIN
                const bf16* Wt = (const bf16*)(ws + WS_WT_SGIN) + (size_t)layer * 2 * SGW * D;
                { pg8::Gemm g{P_HB, Wt, T, SGW, D}; pg8::StaticOrder S; S.init(T, SGW, F.G, (int)blockIdx.x); pg8::EpiBf16<1> E{(bf16*)(ws + WS_U), SGW};
                  GEMM_CALL(pg8::EpiBf16<1>, g, S, E); }
                { pg8::Gemm g{Wt + (size_t)SGW * D, P_HB, SGW, T, D}; pg8::StaticOrder S; S.init(SGW, T, F.G, (int)blockIdx.x); pg8::EpiBf16<1> E{(bf16*)(ws + WS_VT), T};
                  GEMM_CALL(pg8::EpiBf16<1>, g, S, E); }
            PH_END
            PH_BEGIN colss_phase(F); PH_END
            PH_BEGIN spatial_phase(F, layer); PH_END
            PH_BEGIN
                { pg8::Gemm g{(const bf16*)(ws + WS_US), (const bf16*)(ws + WS_WT_SGOUT) + (size_t)layer * D * SGW, T, D, SGW}; pg8::StaticOrder S; S.init(T, D, F.G, (int)blockIdx.x);
                  pg8::EpiResid E{P_XIN, P_XA, D, P_MODS + 2 * D};
                  GEMM_CALL(pg8::EpiResid, g, S, E); }
            PH_END
        } else {
            if (layer == NA) {
                PH_BEGIN
                    { pg8::Gemm g{P_HKV, (const bf16*)(ws + WS_WT_KV), T, NKVC, D}; pg8::StaticOrder S; S.init(T, NKVC, F.G, (int)blockIdx.x); pg8::EpiBf16<0> E{(bf16*)(ws + WS_KV), NKVC};
                      GEMM_CALL(pg8::EpiBf16<0>, g, S, E); }
                PH_END
                PH_BEGIN kvpost_phase(F); PH_END
            }
            PH_BEGIN
                { pg8::Gemm g{P_HB, (const bf16*)(ws + WS_WT_Q) + (size_t)(layer - NA) * D * D, T, D, D}; pg8::StaticOrder S; S.init(T, D, F.G, (int)blockIdx.x); pg8::EpiBf16<0> E{(bf16*)(ws + WS_Q), D};
                  GEMM_CALL(pg8::EpiBf16<0>, g, S, E); }
                gates_phase(F, layer - NA);
            PH_END
            PH_BEGIN attn_phase(F, layer - NA); PH_END
            PH_BEGIN
                { pg8::Gemm g{(const bf16*)(ws + WS_ATT), (const bf16*)(ws + WS_WT_O) + (size_t)(layer - NA) * D * D, T, D, D}; pg8::StaticOrder S; S.init(T, D, F.G, (int)blockIdx.x);
                  pg8::EpiResid E{P_XIN, P_XA, D, P_MODS + 2 * D};
                  GEMM_CALL(pg8::EpiResid, g, S, E); }
            PH_END
        }
        PH_BEGIN { const float* mods = P_MODS; rowmod_phase<false>(F, P_XA, P_NG + D, mods + 3 * D, mods + 4 * D, P_HB, nullptr, nullptr, nullptr, nullptr); } PH_END
        PH_BEGIN
            { pg8::Gemm g{P_HB, (const bf16*)(ws + WS_WT_UP) + (size_t)layer * DFF2 * D, T, DFF2, D}; pg8::StaticOrder S; S.init(T, DFF2, F.G, (int)blockIdx.x); pg8::EpiBf16<0> E{(bf16*)(ws + WS_Z), DFF2};
              GEMM_CALL(pg8::EpiBf16<0>, g, S, E); }
        PH_END
        PH_BEGIN convgate_phase(F, layer); PH_END
        PH_BEGIN
            { pg8::Gemm g{(const bf16*)(ws + WS_G), (const bf16*)(ws + WS_WT_DOWN) + (size_t)layer * D * DFF, T, D, DFF}; pg8::StaticOrder S; S.init(T, D, F.G, (int)blockIdx.x);
              pg8::EpiResid E{P_XA, P_XOUT, D, P_MODS + 5 * D};
              GEMM_CALL(pg8::EpiResid, g, S, E); }
        PH_END
    }
#undef PH_BEGIN
#undef PH_END
}

extern "C" void kernel_launch(void* const* d_in, const int* in_sizes, int n_in, void* d_out, int out_size, void* d_ws, size_t ws_size, hipStream_t stream) {
    static int grid = 0;
    if (grid == 0) {
        if (n_in != 25 || in_sizes[0] != T * D || out_size != T * D || ws_size < WS_END) { fprintf(stderr, "kernel_launch: unexpected shapes (n_in %d, in0 %d, out %d, ws %zu)\n", n_in, n_in > 0 ? in_sizes[0] : -1, out_size, ws_size); grid = -1; return; }
        int dev = 0, cus = 0, per_cu = 0;
        if (hipGetDevice(&dev) != hipSuccess || hipDeviceGetAttribute(&cus, hipDeviceAttributeMultiprocessorCount, dev) != hipSuccess) { grid = -1; return; }
        if (hipFuncSetAttribute((const void*)yoco_fwd, hipFuncAttributeMaxDynamicSharedMemorySize, LDS_BYTES) != hipSuccess) { fprintf(stderr, "kernel_launch: hipFuncSetAttribute failed\n"); grid = -1; return; }
        if (hipOccupancyMaxActiveBlocksPerMultiprocessor(&per_cu, (const void*)yoco_fwd, NWAVES * 64, LDS_BYTES) != hipSuccess || per_cu < 1)
            fprintf(stderr, "kernel_launch: note: occupancy query reports %d workgroups per CU\n", per_cu);
        (void)hipGetLastError();
        grid = cus;
    }
    if (grid < 0) return;
    if (hipMemsetAsync((char*)d_ws + WS_CTL, 0, CTL_ZERO_BYTES, stream) != hipSuccess) { fprintf(stderr, "kernel_launch: memset failed\n"); return; }
    Args a{};
    for (int i = 0; i < 25; ++i) a.in[i] = (const float*)d_in[i];
    a.out = (float*)d_out; a.ws = (unsigned char*)d_ws;
#if MK_ONE_LAUNCH
    a.ph_lo = 0; a.ph_hi = NPHASES;
    hipLaunchKernelGGL(yoco_fwd, dim3(grid), dim3(NWAVES * 64), LDS_BYTES, stream, a);
#else
    for (int p = 0; p < NPHASES; ++p) { a.ph_lo = p; a.ph_hi = p + 1; hipLaunchKernelGGL(yoco_fwd, dim3(grid), dim3(NWAVES * 64), LDS_BYTES, stream, a); }
#endif
    const hipError_t le = hipPeekAtLastError();
    if (le != hipSuccess) fprintf(stderr, "kernel_launch: launch failed: %s\n", hipGetErrorName(le));
}
```

```cpp
#include <hip/hip_runtime.h>
#include <cstdio>
#include <cstdint>
namespace pg8 {
#define PG8_LAS __attribute__((address_space(3)))
typedef unsigned short bf16_t;
typedef short bf16x8 __attribute__((ext_vector_type(8)));
typedef float f32x4 __attribute__((ext_vector_type(4)));
typedef unsigned u32x4 __attribute__((ext_vector_type(4)));
constexpr int BM = 256, BK = 64, HALF = 128, HTB = HALF * BK * 2  , STAGE_BYTES = 8 * HTB, NXCD = 8, WGM = 8;

__host__ __device__ __forceinline__ int lds_byte(int r, int c) { const int st = (r >> 4) * 2 + (c >> 5), rr = r & 15, cc = c & 31, ob = rr * 64 + cc * 2; return st * 1024 + (ob ^ (((ob >> 9) & 1) << 5)); }
__host__ __device__ __forceinline__ void stage_rc(int b, int& R, int& C) { const int st = b / 1024, sb = b % 1024, swz = sb ^ (((sb >> 9) & 1) << 5); R = (st >> 1) * 16 + swz / 64; C = (st & 1) * 32 + (swz % 64) / 2; }
__host__ __device__ __forceinline__ int perm32(int rho) { const int n = rho >> 4, i = rho & 15; return 8 * (i >> 2) + 4 * n + (i & 3); }

struct Unit { int pm, pn; };
struct Gemm { const bf16_t* A; const bf16_t* Bt; int M, N, K; };

struct StaticOrder {
    int nM, nN, nwg, G, c;
    __host__ __device__ void init(int M, int N, int G_, int c_) { nM = M / BM; nN = N / BM; nwg = nM * nN; G = G_; c = c_; }
    __host__ __device__ bool next(int i, Unit& u) const {
        const long L = (long)i * G + c; if (L >= nwg) return false;
        int wgid = (int)L; { const int q = nwg / NXCD, r = nwg % NXCD, xcd = wgid % NXCD, off = wgid / NXCD; wgid = (xcd < r ? xcd * (q + 1) : r * (q + 1) + (xcd - r) * q) + off; }
        const int nig = WGM * nN, gid = wgid / nig, fm = gid * WGM, gsz = (nM - fm) < WGM ? (nM - fm) : WGM;
        u.pm = fm + ((wgid % nig) % gsz); u.pn = (wgid % nig) / gsz; return true;
    }
    __device__ __forceinline__ void a_ready(const Unit&) const {}
    __device__ __forceinline__ void done(const Unit&) const {}
};


__device__ __forceinline__ unsigned cvt_pk_bf16(float lo, float hi) { unsigned r; asm volatile("v_cvt_pk_bf16_f32 %0, %1, %2" : "=v"(r) : "v"(lo), "v"(hi)); return r; }
__device__ __forceinline__ float gelu_tanh(float v) {
    const float inner = v * (1.0f + 0.044715f * v * v);
    const float e = __builtin_amdgcn_exp2f(-2.3022081997f * inner);
    return v * __builtin_amdgcn_rcpf(1.0f + e);
}
template <int ACT  > struct EpiBf16 {
    static constexpr bool PERM = true, AFTER_DRAIN = false;
    bf16_t* O; int ldc;
    __device__ __forceinline__ void operator()(const f32x4 (&acc)[2][2][4][2], const Unit& u, int wr, int wc, int fr, int fq) const {
        const int row0 = u.pm * BM + wr * 64 + fr; const int col0 = u.pn * BM + wc * 32 + 8 * fq;
#pragma unroll
        for (int ai = 0; ai < 2; ++ai)
#pragma unroll
            for (int m = 0; m < 4; ++m) { bf16_t* rowp = O + (size_t)(row0 + ai * HALF + m * 16) * ldc + col0;
#pragma unroll
                for (int bj = 0; bj < 2; ++bj) { f32x4 v0 = acc[ai][bj][m][0], v1 = acc[ai][bj][m][1];
                    if (ACT == 1) {
#pragma unroll
                        for (int j = 0; j < 4; ++j) { v0[j] = gelu_tanh(v0[j]); v1[j] = gelu_tanh(v1[j]); } }
                    u32x4 w; w.x = cvt_pk_bf16(v0[0], v0[1]); w.y = cvt_pk_bf16(v0[2], v0[3]); w.z = cvt_pk_bf16(v1[0], v1[1]); w.w = cvt_pk_bf16(v1[2], v1[3]);
                    *(u32x4*)(rowp + bj * HALF) = w; } }
    }
};
struct EpiResid {
    static constexpr bool PERM = false, AFTER_DRAIN = false;
    const float* base; float* out; int ldc; const float* gate;
    __device__ __forceinline__ void operator()(const f32x4 (&acc)[2][2][4][2], const Unit& u, int wr, int wc, int fr, int fq) const {
        const int row0 = u.pm * BM + wr * 64 + fr, col0 = u.pn * BM + wc * 32 + 4 * fq;
        f32x4 gv[2][2];
#pragma unroll
        for (int bj = 0; bj < 2; ++bj)
#pragma unroll
            for (int n = 0; n < 2; ++n) gv[bj][n] = *(const f32x4*)(gate + col0 + bj * HALF + n * 16);
#pragma unroll
        for (int ai = 0; ai < 2; ++ai)
#pragma unroll
            for (int m = 0; m < 4; ++m) { const size_t off = (size_t)(row0 + ai * HALF + m * 16) * ldc + col0;
#pragma unroll
                for (int bj = 0; bj < 2; ++bj)
#pragma unroll
                    for (int n = 0; n < 2; ++n) { const f32x4 bs = *(const f32x4*)(base + off + bj * HALF + n * 16);
                        *(f32x4*)(out + off + bj * HALF + n * 16) = bs + gv[bj][n] * acc[ai][bj][m][n]; } }
    }
};
template <class Epi, class Sched, bool ALIGN_EPI = false, bool SP2 = false>
__device__ __forceinline__ void gemm_phase(PG8_LAS unsigned char* lds, const Gemm g, const Sched& S, const Epi& E, const int tid) {
    const int wid = __builtin_amdgcn_readfirstlane(tid >> 6), lane = tid & 63, wr = wid >> 2, wc = wid & 3, fr = lane & 15, fq = lane >> 4;
    const int K = g.K, nt = K / BK;
    unsigned voffA[2], voffB[2];
#pragma unroll
    for (int i = 0; i < 2; ++i) { int R, C; stage_rc(tid * 16 + i * 8192, R, C); const int Rb = Epi::PERM ? ((R & ~31) + perm32(R & 31)) : R;
        voffA[i] = (unsigned)(R * K + C) * 2u; voffB[i] = (unsigned)(Rb * K + C) * 2u; }
    const size_t kstep = (size_t)(BK * 2);
    const size_t hstep = (size_t)HALF * K * 2;
    const size_t tstep = 2 * hstep;
    const unsigned ldsw = (unsigned)wid * 1024u;
    const int aoff = lds_byte(wr * 64 + fr, fq * 8), boff = lds_byte(wc * 32 + fr, fq * 8);
#define PG8_SA(b, h) (((b) * 2 + (h)) * HTB)
#define PG8_SB(b, h) ((4 + (b) * 2 + (h)) * HTB)
#define PG8_STAGE(bufoff, gbase, voff) do { _Pragma("unroll") for (int _i = 0; _i < 2; ++_i) \
        __builtin_amdgcn_global_load_lds((const unsigned*)((const char*)(gbase) + (voff)[_i]), (PG8_LAS unsigned*)(lds + (bufoff) + ldsw + _i * 8192), 16, 0, 0); } while (0)
#define PG8_LDA(dst, b, h) do { _Pragma("unroll") for (int m = 0; m < 4; ++m) _Pragma("unroll") for (int k = 0; k < 2; ++k) dst[m][k] = *(const PG8_LAS bf16x8*)(lds + PG8_SA(b, h) + aoff + m * 2048 + k * 1024); } while (0)
#define PG8_LDB(dst, b, h) do { _Pragma("unroll") for (int n = 0; n < 2; ++n) _Pragma("unroll") for (int k = 0; k < 2; ++k) dst[n][k] = *(const PG8_LAS bf16x8*)(lds + PG8_SB(b, h) + boff + n * 2048 + k * 1024); } while (0)
#define PG8_MMA(ai, bj, At, Bt) do { __builtin_amdgcn_s_setprio(1); _Pragma("unroll") for (int m = 0; m < 4; ++m) _Pragma("unroll") for (int n = 0; n < 2; ++n) _Pragma("unroll") for (int k = 0; k < 2; ++k) \
        acc[ai][bj][m][n] = __builtin_amdgcn_mfma_f32_16x16x32_bf16(Bt[n][k], At[m][k], acc[ai][bj][m][n], 0, 0, 0); __builtin_amdgcn_s_setprio(0); } while (0)
#define PG8_WAIT_V(n) asm volatile("s_waitcnt vmcnt(" #n ")" ::: "memory")
#define PG8_WAIT_L(n) asm volatile("s_waitcnt lgkmcnt(" #n ")" ::: "memory")
#define PG8_BAR __builtin_amdgcn_s_barrier()
#define PG8_SCHED __builtin_amdgcn_sched_barrier(0)
    Unit cur, nxt; int ui = 0;
    if (!S.next(0, cur)) return;
    f32x4 acc[2][2][4][2];
#pragma unroll
    for (int a = 0; a < 2; ++a)
#pragma unroll
        for (int b = 0; b < 2; ++b)
#pragma unroll
            for (int m = 0; m < 4; ++m)
#pragma unroll
                for (int n = 0; n < 2; ++n) acc[a][b][m][n] = (f32x4){0.f, 0.f, 0.f, 0.f};
    bf16x8 At[4][2], B0[2][2], B1[2][2];
    const char* cA = (const char*)g.A + (size_t)cur.pm * tstep; const char* cB = (const char*)g.Bt + (size_t)cur.pn * tstep;
    S.a_ready(cur);
    if constexpr (SP2) {
        PG8_STAGE(PG8_SB(0, 0), cB, voffB); PG8_STAGE(PG8_SB(0, 1), cB + hstep, voffB); PG8_STAGE(PG8_SA(0, 0), cA, voffA); PG8_STAGE(PG8_SA(0, 1), cA + hstep, voffA);
        if (wr == 1) PG8_BAR;
        PG8_WAIT_V(2); PG8_BAR;
        PG8_STAGE(PG8_SB(1, 0), cB + kstep, voffB); PG8_STAGE(PG8_SA(1, 0), cA + kstep, voffA); PG8_STAGE(PG8_SB(1, 1), cB + hstep + kstep, voffB);
        PG8_WAIT_V(6); PG8_BAR;
    } else {
        PG8_STAGE(PG8_SB(0, 0), cB, voffB); PG8_STAGE(PG8_SA(0, 0), cA, voffA); PG8_STAGE(PG8_SB(0, 1), cB + hstep, voffB); PG8_STAGE(PG8_SA(0, 1), cA + hstep, voffA);
        if (wr == 1) PG8_BAR;
        PG8_WAIT_V(4); PG8_BAR;
        PG8_STAGE(PG8_SB(1, 0), cB + kstep, voffB); PG8_STAGE(PG8_SA(1, 0), cA + kstep, voffA); PG8_STAGE(PG8_SB(1, 1), cB + hstep + kstep, voffB);
        PG8_WAIT_V(6); PG8_BAR;
    }
    for (;;) {
        const bool has_next = S.next(ui + 1, nxt);
        const char* nA = has_next ? (const char*)g.A + (size_t)nxt.pm * tstep : cA; const char* nB = has_next ? (const char*)g.Bt + (size_t)nxt.pn * tstep : cB;
        for (int t = 0; t < nt; t += 2) {
            const bool last = (t == nt - 2);
            const char* a1 = cA + (size_t)(t + 1) * kstep;
            const char* a2 = last ? nA : cA + (size_t)(t + 2) * kstep; const char* b2 = last ? nB : cB + (size_t)(t + 2) * kstep;
            const char* a3 = a2 + kstep; const char* b3 = b2 + kstep;
            if (last && has_next) S.a_ready(nxt);
            if constexpr (SP2) {
            PG8_LDB(B0, 0, 0); PG8_LDB(B1, 0, 1); PG8_SCHED; PG8_LDA(At, 0, 0); PG8_STAGE(PG8_SA(1, 1), a1 + hstep, voffA);
            PG8_WAIT_V(8); PG8_WAIT_L(0); PG8_BAR; PG8_MMA(0, 0, At, B0); PG8_MMA(0, 1, At, B1); PG8_BAR; PG8_SCHED;
            PG8_LDA(At, 0, 1); PG8_STAGE(PG8_SB(0, 0), b2, voffB); PG8_STAGE(PG8_SB(0, 1), b2 + hstep, voffB); PG8_STAGE(PG8_SA(0, 0), a2, voffA);
            PG8_WAIT_V(8); PG8_WAIT_L(0); PG8_BAR; PG8_MMA(1, 0, At, B0); PG8_MMA(1, 1, At, B1); PG8_BAR; PG8_SCHED;
            PG8_LDB(B0, 1, 0); PG8_LDB(B1, 1, 1); PG8_SCHED; PG8_LDA(At, 1, 0); PG8_STAGE(PG8_SA(0, 1), a2 + hstep, voffA);
            PG8_WAIT_V(8); PG8_WAIT_L(0); PG8_BAR; PG8_MMA(0, 0, At, B0); PG8_MMA(0, 1, At, B1); PG8_BAR; PG8_SCHED;
            PG8_LDA(At, 1, 1); PG8_STAGE(PG8_SB(1, 0), b3, voffB); PG8_STAGE(PG8_SB(1, 1), b3 + hstep, voffB); PG8_STAGE(PG8_SA(1, 0), a3, voffA);
            PG8_WAIT_V(8); PG8_WAIT_L(0); PG8_BAR; PG8_MMA(1, 0, At, B0); PG8_MMA(1, 1, At, B1); PG8_BAR; PG8_SCHED;
            } else {
            PG8_LDB(B0, 0, 0); PG8_SCHED; PG8_LDA(At, 0, 0); PG8_STAGE(PG8_SA(1, 1), a1 + hstep, voffA);
            PG8_WAIT_L(8); PG8_BAR; PG8_WAIT_L(0); PG8_MMA(0, 0, At, B0); PG8_BAR; PG8_SCHED;
            PG8_LDB(B1, 0, 1); PG8_STAGE(PG8_SB(0, 0), b2, voffB);
            PG8_BAR; PG8_WAIT_L(0); PG8_MMA(0, 1, At, B1); PG8_BAR;
            PG8_LDA(At, 0, 1); PG8_STAGE(PG8_SA(0, 0), a2, voffA);
            PG8_BAR; PG8_WAIT_L(0); PG8_MMA(1, 0, At, B0); PG8_BAR; PG8_SCHED;
            PG8_STAGE(PG8_SB(0, 1), b2 + hstep, voffB);
            PG8_WAIT_V(6); PG8_BAR; PG8_MMA(1, 1, At, B1); PG8_BAR;
            PG8_LDB(B0, 1, 0); PG8_SCHED; PG8_LDA(At, 1, 0); PG8_STAGE(PG8_SA(0, 1), a2 + hstep, voffA);
            PG8_WAIT_L(8); PG8_BAR; PG8_WAIT_L(0); PG8_MMA(0, 0, At, B0); PG8_BAR; PG8_SCHED;
            PG8_LDB(B1, 1, 1); PG8_STAGE(PG8_SB(1, 0), b3, voffB);
            PG8_BAR; PG8_WAIT_L(0); PG8_MMA(0, 1, At, B1); PG8_BAR;
            PG8_LDA(At, 1, 1); PG8_STAGE(PG8_SA(1, 0), a3, voffA);
            PG8_BAR; PG8_WAIT_L(0); PG8_MMA(1, 0, At, B0); PG8_BAR; PG8_SCHED;
            PG8_STAGE(PG8_SB(1, 1), b3 + hstep, voffB);
            PG8_WAIT_V(6); PG8_BAR; PG8_MMA(1, 1, At, B1); PG8_BAR;
            }
        }
        if constexpr (ALIGN_EPI) { if (wr == 0) PG8_BAR; }
        if constexpr (!Epi::AFTER_DRAIN) { E(acc, cur, wr, wc, fr, fq); S.done(cur); }
        if (!has_next) break;
#pragma unroll
        for (int a = 0; a < 2; ++a)
#pragma unroll
            for (int b = 0; b < 2; ++b)
#pragma unroll
                for (int m = 0; m < 4; ++m)
#pragma unroll
                    for (int n = 0; n < 2; ++n) acc[a][b][m][n] = (f32x4){0.f, 0.f, 0.f, 0.f};
        cur = nxt; cA = nA; cB = nB; ++ui;
        if constexpr (ALIGN_EPI) { if (wr == 1) PG8_BAR; }
    }
    PG8_WAIT_V(0);
    if constexpr (!ALIGN_EPI) { if (wr == 0) PG8_BAR; }
    PG8_BAR;
    if constexpr (Epi::AFTER_DRAIN) { E.fused(acc, cur, wr, wc, fr, fq, lds, wid, lane); S.done(cur); }
#undef PG8_SA
#undef PG8_SB
#undef PG8_STAGE
#undef PG8_LDA
#undef PG8_LDB
#undef PG8_MMA
#undef PG8_WAIT_V
#undef PG8_WAIT_L
#undef PG8_BAR
#undef PG8_SCHED
}
}

#ifndef PG8_SP2
#define PG8_SP2 true
#endif
#ifndef PG8_ALIGN
#define PG8_ALIGN true
#endif
#ifndef MK_ONE_LAUNCH
#define MK_ONE_LAUNCH 1
#endif

constexpr int NWAVES = 8;
constexpr int T = 8192, D = 2048, DEPTH = 4, NA = 2;
constexpr int SGW = 4096, SGG = 16, SGD = 256, CHUNK = 128;
constexpr int DFF = 5632, DFF2 = 11264;
constexpr int NH = 16, HD = 128, NKV = 4, NKVC = 3072;
constexpr int NCMP = 511, NSLC = 128, WIN = 512;
constexpr int NQG = 2096;
constexpr int NMOD = 12288;
constexpr float EPS = 1e-6f;
constexpr float NEGBIG = -1e30f;

constexpr size_t MiB = 1u << 20;
constexpr size_t WS_CTL = 0, CTL_ZERO_BYTES = 1 * MiB;
constexpr size_t WS_MODS = 1 * MiB;
constexpr size_t WS_KVMOD = WS_MODS + 4 * NMOD * 4;
constexpr size_t WS_POSB = WS_KVMOD + 4096 * 4;
constexpr size_t WS_WSB = 2 * MiB;
constexpr size_t WS_SSP = 3 * MiB;
constexpr size_t WS_GATES = 4 * MiB;
constexpr size_t WS_KC = 6 * MiB, WS_VC = 7 * MiB;
constexpr size_t WS_W1T = 8 * MiB;
constexpr size_t WS_W2T = 10 * MiB;
constexpr size_t WS_WGT = 11 * MiB;
constexpr size_t WS_WT_SGIN = 16 * MiB;
constexpr size_t WS_WT_SGOUT = 80 * MiB;
constexpr size_t WS_WT_UP = 112 * MiB;
constexpr size_t WS_WT_DOWN = 288 * MiB;
constexpr size_t WS_WT_KV = 376 * MiB;
constexpr size_t WS_WT_Q = 388 * MiB;
constexpr size_t WS_WT_O = 404 * MiB;
constexpr size_t WS_XA = 420 * MiB, WS_XB = 484 * MiB;
constexpr size_t WS_H = 548 * MiB, WS_HKV = 580 * MiB;
constexpr size_t WS_U = 612 * MiB, WS_VT = 676 * MiB, WS_US = 740 * MiB;
constexpr size_t WS_Z = 804 * MiB;
constexpr size_t WS_G = 980 * MiB;
constexpr size_t WS_KV = 1068 * MiB;
constexpr size_t WS_Q = 1116 * MiB, WS_ATT = 1148 * MiB;
constexpr size_t WS_END = 1180 * MiB;
constexpr int CW_BAR = 4096;

constexpr int RING_OFF = 0, RING_BYTES = 131072;
constexpr int LDSCTL_OFF = RING_BYTES, MISC_OFF = LDSCTL_OFF + 320;
constexpr int LDS_BYTES = 147456;
static_assert(MISC_OFF + 128 <= LDS_BYTES, "LDS map");

#define GAS __attribute__((address_space(1)))
#define LAS __attribute__((address_space(3)))
typedef unsigned short bf16;
typedef unsigned v4u __attribute__((ext_vector_type(4)));
typedef unsigned v2u __attribute__((ext_vector_type(2)));
typedef float f32x4 __attribute__((ext_vector_type(4)));
typedef short bf16x8 __attribute__((ext_vector_type(8)));
typedef GAS unsigned gu32;
#define RLX_AGENT __ATOMIC_RELAXED, __HIP_MEMORY_SCOPE_AGENT
#define LDS_WAIT() asm volatile("s_waitcnt lgkmcnt(0)" ::: "memory")
#define VM_WAIT() asm volatile("s_waitcnt vmcnt(0)" ::: "memory")
__device__ __forceinline__ unsigned f2bf(float f) { unsigned u = __builtin_bit_cast(unsigned, f); return (u + 0x7fffu + ((u >> 16) & 1u)) >> 16; }
__device__ __forceinline__ unsigned pk2(float lo, float hi) { return f2bf(lo) | (f2bf(hi) << 16); }
__device__ __forceinline__ float bflo(unsigned w) { return __builtin_bit_cast(float, w << 16); }
__device__ __forceinline__ float bfhi(unsigned w) { return __builtin_bit_cast(float, w & 0xffff0000u); }
__device__ __forceinline__ float bf1(bf16 b) { return __builtin_bit_cast(float, (unsigned)b << 16); }
__device__ __forceinline__ float silu_f(float v) { return v * __builtin_amdgcn_rcpf(1.0f + __builtin_amdgcn_exp2f(-1.4426950409f * v)); }
__device__ __forceinline__ float sigmoid_f(float v) { return __builtin_amdgcn_rcpf(1.0f + __builtin_amdgcn_exp2f(-1.4426950409f * v)); }

#define XB_TMO      128
#define XB_XCNT(j)  (256  + 64 * (j))
#define XB_XSUB(j)  (1280 + 64 * (j))
#define XB_XGEN(j)  (2304 + 64 * (j))
#define XB_TOP      3328
#define XB_TOPGEN   3392
#define XCD_BAR_WORDS 3456
#define XB_SPIN_CAP (1u << 18)

__device__ __forceinline__ unsigned xb_ld(unsigned* p)              { return __hip_atomic_load(p, __ATOMIC_RELAXED, __HIP_MEMORY_SCOPE_AGENT); }
__device__ __forceinline__ unsigned xb_add(unsigned* p, unsigned v) { return __hip_atomic_fetch_add(p, v, __ATOMIC_RELAXED, __HIP_MEMORY_SCOPE_AGENT); }
__device__ __forceinline__ unsigned xb_xcc_id() { return (unsigned)__builtin_amdgcn_s_getreg((3 << 11) | 20) & 0xFu; }
#define XB_SPIN(cond, bar) do { unsigned _sp = 0; while (cond) { __builtin_amdgcn_s_sleep(1); \
    if ((++_sp & 255u) == 0u) { if (xb_ld(&(bar)[XB_TMO])) break; if (_sp > XB_SPIN_CAP) { atomicAdd(&(bar)[XB_TMO], 1u); break; } } } } while (0)

struct XcdBarrier {
    unsigned* bar; unsigned x;
    volatile LAS unsigned* st;
};

__device__ __forceinline__ XcdBarrier xcd_barrier_post(unsigned* bar, volatile LAS unsigned* st) {
    XcdBarrier b; b.bar = bar; b.x = xb_xcc_id(); b.st = st;
    if (threadIdx.x == 0) (void)xb_add(&bar[XB_XCNT(b.x)], 1u);
    return b;
}
__device__ __forceinline__ void xcd_barrier_complete(unsigned* bar, unsigned x, unsigned& nloc, unsigned& nx) {
    const unsigned G = gridDim.x * gridDim.y * gridDim.z;
    unsigned sum, cnt, mine, sp = 0u;
    for (;;) {
        sum = 0u; cnt = 0u; mine = 0u;
#pragma unroll
        for (unsigned j = 0; j < 16; ++j) { const unsigned c = xb_ld(&bar[XB_XCNT(j)]); sum += c; cnt += (c > 0u) ? 1u : 0u; mine = (j == x) ? c : mine; }
        if (sum == G) break;
        __builtin_amdgcn_s_sleep(1);
        if ((++sp & 255u) == 0u) { if (xb_ld(&bar[XB_TMO])) break; if (sp > XB_SPIN_CAP) { atomicAdd(&bar[XB_TMO], 1u); break; } }
    }
    nloc = mine > 0u ? mine : 1u; nx = cnt > 0u ? cnt : 1u;
}

__device__ __forceinline__ void xcd_barrier(const XcdBarrier& b) {
    asm volatile("s_waitcnt vmcnt(0)" ::: "memory");
    __syncthreads();
    if (threadIdx.x == 0) {
        unsigned* bar = b.bar;
        __builtin_amdgcn_s_waitcnt(0);
        unsigned nloc = b.st[0], nx = b.st[1];
        if (nloc == 0u) { xcd_barrier_complete(bar, b.x, nloc, nx); b.st[0] = nloc; b.st[1] = nx; }
        const unsigned old = xb_add(&bar[XB_XSUB(b.x)], 1u);
        const unsigned gen = old / nloc;
        if (old + 1u == (gen + 1u) * nloc) {
            __builtin_amdgcn_fence(__ATOMIC_RELEASE, "agent");
            asm volatile("s_waitcnt vmcnt(0)" ::: "memory");
            const unsigned og = xb_add(&bar[XB_TOP], 1u);
            const unsigned tg = og / nx;
            if (og + 1u == (tg + 1u) * nx) xb_add(&bar[XB_TOPGEN], 1u);
            else XB_SPIN(xb_ld(&bar[XB_TOPGEN]) == tg, bar);
            __builtin_amdgcn_fence(__ATOMIC_ACQUIRE, "agent");
            xb_add(&bar[XB_XGEN(b.x)], 1u);
            asm volatile("s_waitcnt vmcnt(0)" ::: "memory");
        } else {
            XB_SPIN(xb_ld(&bar[XB_XGEN(b.x)]) == gen, bar);
            __builtin_amdgcn_fence(__ATOMIC_ACQUIRE, "agent");
            asm volatile("s_waitcnt vmcnt(0)" ::: "memory");
        }
    }
    __syncthreads();
}

struct Frame {
    LAS unsigned char* lds;
    int tid, lane, wave;
    int vcu, G;
    unsigned char* ws;
};
__device__ __forceinline__ const float* in_ptr(const Frame& F, int i) {
    const volatile LAS unsigned* p = (const volatile LAS unsigned*)(F.lds + LDSCTL_OFF) + 2 * i;
    const unsigned lo = __builtin_amdgcn_readfirstlane(p[0]), hi = __builtin_amdgcn_readfirstlane(p[1]);
    return (const float*)(((unsigned long long)hi << 32) | lo);
}
__device__ __forceinline__ float wave_sum(float v) {
#pragma unroll
    for (int o = 1; o < 64; o <<= 1) v += __shfl_xor(v, o);
    return v;
}
__device__ __forceinline__ float wave_max(float v) {
#pragma unroll
    for (int o = 1; o < 64; o <<= 1) v = fmaxf(v, __shfl_xor(v, o));
    return v;
}

__device__ __forceinline__ void p0_transpose_item(const float* W, int ldw, int K, int N, bf16* WT, LAS float* scr, int item, int lane) {
    const int nblk = N / 32, kb = item / nblk, nb = item % nblk, k0 = 64 * kb, n0 = 32 * nb;
#pragma unroll 8
    for (int i = 0; i < 32; ++i) { const int kk = 2 * i + (lane >> 5); scr[kk * 33 + (lane & 31)] = W[(size_t)(k0 + kk) * ldw + n0 + (lane & 31)]; }
    LDS_WAIT(); asm volatile("" ::: "memory");
    const int c = lane & 7;
#pragma unroll
    for (int j = 0; j < 4; ++j) { const int n = (lane >> 3) + 8 * j; const LAS float* s = scr + (8 * c) * 33 + n;
        v4u o; o.x = pk2(s[0 * 33], s[1 * 33]); o.y = pk2(s[2 * 33], s[3 * 33]); o.z = pk2(s[4 * 33], s[5 * 33]); o.w = pk2(s[6 * 33], s[7 * 33]);
        *(GAS v4u*)(WT + (size_t)(n0 + n) * K + k0 + 8 * c) = o; }
    LDS_WAIT(); asm volatile("" ::: "memory");
}
__device__ __forceinline__ void p0_gemv_item(Frame& F, int it) {
    const float* W; const float* bias; float* out; int N; int col0;
    if (it < 192) { const int l = it / 48, cb = it % 48; W = in_ptr(F, 2) + (size_t)l * D * NMOD; N = NMOD; bias = in_ptr(F, 3) + l * NMOD; out = (float*)(F.ws + WS_MODS) + l * NMOD; col0 = cb * 256; }
    else { const int cb = it - 192; W = in_ptr(F, 15); N = 4096; bias = in_ptr(F, 16); out = (float*)(F.ws + WS_KVMOD); col0 = cb * 256; }
    const float* c = in_ptr(F, 1);
    f32x4 acc = (f32x4){0.f, 0.f, 0.f, 0.f};
    const float* wp = W + (size_t)(F.wave * 256) * N + col0 + 4 * F.lane;
#pragma unroll 8
    for (int k = 0; k < 256; ++k) { const float cv = c[F.wave * 256 + k]; const float s = silu_f(cv); const f32x4 w = *(const GAS f32x4*)(wp + (size_t)k * N); acc += s * w; }
    LAS float* red = (LAS float*)F.lds;
    *(LAS f32x4*)(red + F.wave * 256 + 4 * F.lane) = acc;
    __syncthreads();
    if (F.tid < 256) { float s = bias[col0 + F.tid];
#pragma unroll
        for (int w = 0; w < 8; ++w) s += red[w * 256 + F.tid];
        out[col0 + F.tid] = s; }
    __syncthreads();
}
__device__ __forceinline__ void p0_posb_item(Frame& F, int i) {
    const float* pos = in_ptr(F, 18) + i * 4096; const float* W1 = in_ptr(F, 19) + (size_t)i * 4096 * 128;
    float a0 = 0.f, a1 = 0.f;
    for (int k = F.wave * 512; k < F.wave * 512 + 512; ++k) { const float p = pos[k]; a0 += p * W1[k * 128 + F.lane]; a1 += p * W1[k * 128 + 64 + F.lane]; }
    LAS float* red = (LAS float*)F.lds;
    red[F.wave * 128 + F.lane] = a0; red[F.wave * 128 + 64 + F.lane] = a1;
    __syncthreads();
    if (F.tid < 128) { float s = 0.f;
#pragma unroll
        for (int w = 0; w < 8; ++w) s += red[w * 128 + F.tid];
        ((float*)(F.ws + WS_POSB))[i * 128 + F.tid] = s; }
    __syncthreads();
}
__device__ __forceinline__ void p0_prologue(Frame& F) {
    for (int it = F.vcu; it < 210; it += F.G) { if (it < 208) p0_gemv_item(F, it); else p0_posb_item(F, it - 208); }
    { const float* ws_ = in_ptr(F, 11); bf16* o = (bf16*)(F.ws + WS_WSB);
      for (int i = F.vcu * 512 + F.tid; i < 2 * 16 * 128 * 128; i += F.G * 512) { const int s = i & 127, t = (i >> 7) & 127; o[i] = (s <= t) ? (bf16)f2bf(ws_[i]) : (bf16)0; } }
    { const float* wi = in_ptr(F, 22); bf16* o = (bf16*)(F.ws + WS_WGT);
      for (int i = F.vcu * 512 + F.tid; i < 2 * 48 * D; i += F.G * 512) { const int k = i & (D - 1), c = (i >> 11) % 48, b = i / (48 * D); o[i] = (bf16)f2bf(wi[(size_t)b * D * NQG + (size_t)k * NQG + 2048 + c]); } }
    LAS float* scr = (LAS float*)(F.lds + RING_OFF + F.wave * 16384);
    const int gw = F.vcu * NWAVES + F.wave, NGW = F.G * NWAVES;
    constexpr int I_SGIN = (D / 64) * (2 * SGW / 32), I_SGOUT = (SGW / 64) * (D / 32), I_UP = (D / 64) * (DFF2 / 32), I_DOWN = (DFF / 64) * (D / 32);
    constexpr int I_KV = (D / 64) * (NKVC / 32), I_Q = (D / 64) * (D / 32), I_O = I_Q;
    constexpr int I_W1 = (4096 / 64) * (128 / 32), I_W2 = (128 / 64) * (128 / 32);
    constexpr int NITEMS = 2 * I_SGIN + 2 * I_SGOUT + 4 * I_UP + 4 * I_DOWN + I_KV + 2 * I_Q + 2 * I_O + 2 * I_W1 + 2 * I_W2;
    for (int it = gw; it < NITEMS; it += NGW) {
        int r = it;
        if (r < 2 * I_SGIN) { const int a = r / I_SGIN; r -= a * I_SGIN; p0_transpose_item(in_ptr(F, 9) + (size_t)a * D * 2 * SGW, 2 * SGW, D, 2 * SGW, (bf16*)(F.ws + WS_WT_SGIN) + (size_t)a * 2 * SGW * D, scr, r, F.lane); continue; } r -= 2 * I_SGIN;
        if (r < 2 * I_SGOUT) { const int a = r / I_SGOUT; r -= a * I_SGOUT; p0_transpose_item(in_ptr(F, 13) + (size_t)a * SGW * D, D, SGW, D, (bf16*)(F.ws + WS_WT_SGOUT) + (size_t)a * D * SGW, scr, r, F.lane); continue; } r -= 2 * I_SGOUT;
        if (r < 4 * I_UP) { const int a = r / I_UP; r -= a * I_UP; p0_transpose_item(in_ptr(F, 5) + (size_t)a * D * DFF2, DFF2, D, DFF2, (bf16*)(F.ws + WS_WT_UP) + (size_t)a * DFF2 * D, scr, r, F.lane); continue; } r -= 4 * I_UP;
        if (r < 4 * I_DOWN) { const int a = r / I_DOWN; r -= a * I_DOWN; p0_transpose_item(in_ptr(F, 8) + (size_t)a * DFF * D, D, DFF, D, (bf16*)(F.ws + WS_WT_DOWN) + (size_t)a * D * DFF, scr, r, F.lane); continue; } r -= 4 * I_DOWN;
        if (r < I_KV) { p0_transpose_item(in_ptr(F, 17), NKVC, D, NKVC, (bf16*)(F.ws + WS_WT_KV), scr, r, F.lane); continue; } r -= I_KV;
        if (r < 2 * I_Q) { const int a = r / I_Q; r -= a * I_Q; p0_transpose_item(in_ptr(F, 22) + (size_t)a * D * NQG, NQG, D, D, (bf16*)(F.ws + WS_WT_Q) + (size_t)a * D * D, scr, r, F.lane); continue; } r -= 2 * I_Q;
        if (r < 2 * I_O) { const int a = r / I_O; r -= a * I_O; p0_transpose_item(in_ptr(F, 24) + (size_t)a * D * D, D, D, D, (bf16*)(F.ws + WS_WT_O) + (size_t)a * D * D, scr, r, F.lane); continue; } r -= 2 * I_O;
        if (r < 2 * I_W1) { const int a = r / I_W1; r -= a * I_W1; p0_transpose_item(in_ptr(F, 19) + (size_t)a * 4096 * 128, 128, 4096, 128, (bf16*)(F.ws + WS_W1T) + (size_t)a * 128 * 4096, scr, r, F.lane); continue; } r -= 2 * I_W1;
        { const int a = r / I_W2; r -= a * I_W2; p0_transpose_item(in_ptr(F, 20) + (size_t)a * 128 * 128, 128, 128, 128, (bf16*)(F.ws + WS_W2T) + (size_t)a * 128 * 128, scr, r, F.lane); }
    }
}

template <bool DUAL>
__device__ __forceinline__ void rowmod_phase(Frame& F, const float* x, const float* gain, const float* shift, const float* scale, bf16* out,
                                             const float* gain2, const float* shift2, const float* scale2, bf16* out2) {
    const int gw = F.vcu * NWAVES + F.wave, NGW = F.G * NWAVES;
    f32x4 ca[8], cb[8], ca2[8], cb2[8];
#pragma unroll
    for (int j = 0; j < 8; ++j) { const int c = 4 * F.lane + 256 * j;
        const f32x4 g = *(const GAS f32x4*)(gain + c), sc = *(const GAS f32x4*)(scale + c); ca[j] = g * (sc + 1.0f); cb[j] = *(const GAS f32x4*)(shift + c);
        if (DUAL) { const f32x4 g2 = *(const GAS f32x4*)(gain2 + c), sc2 = *(const GAS f32x4*)(scale2 + c); ca2[j] = g2 * (sc2 + 1.0f); cb2[j] = *(const GAS f32x4*)(shift2 + c); } }
    for (int m = gw; m < T; m += NGW) {
        const GAS f32x4* xr = (const GAS f32x4*)(x + (size_t)m * D) + F.lane;
        f32x4 v[8]; float s = 0.f;
#pragma unroll
        for (int j = 0; j < 8; ++j) { v[j] = xr[64 * j]; s += (v[j].x * v[j].x + v[j].y * v[j].y) + (v[j].z * v[j].z + v[j].w * v[j].w); }
        const float rstd = 1.0f / sqrtf(wave_sum(s) * (1.0f / D) + EPS);
        GAS v2u* o8 = (GAS v2u*)(out + (size_t)m * D) + F.lane;
#pragma unroll
        for (int j = 0; j < 8; ++j) { const f32x4 y = v[j] * rstd * ca[j] + cb[j]; v2u w; w.x = pk2(y.x, y.y); w.y = pk2(y.z, y.w); o8[64 * j] = w; }
        if (DUAL) { GAS v2u* p8 = (GAS v2u*)(out2 + (size_t)m * D) + F.lane;
#pragma unroll
            for (int j = 0; j < 8; ++j) { const f32x4 y = v[j] * rstd * ca2[j] + cb2[j]; v2u w; w.x = pk2(y.x, y.y); w.y = pk2(y.z, y.w); p8[64 * j] = w; } }
    }
}

__device__ __forceinline__ void colss_phase(Frame& F) {
    const bf16* VT = (const bf16*)(F.ws + WS_VT); float* SSP = (float*)(F.ws + WS_SSP);
    LAS float* red = (LAS float*)F.lds;
    for (int it = F.vcu; it < 512; it += F.G) {
        const int tb = it >> 5, cb = it & 31; const int t0 = tb * 512 + 8 * F.lane;
        float a[8];
#pragma unroll
        for (int e = 0; e < 8; ++e) a[e] = 0.f;
#pragma unroll 4
        for (int i = 0; i < 16; ++i) { const v4u v = *(const GAS v4u*)(VT + (size_t)(cb * 128 + F.wave * 16 + i) * T + t0);
            const unsigned w[4] = {v.x, v.y, v.z, v.w};
#pragma unroll
            for (int q = 0; q < 4; ++q) { const float lo = bflo(w[q]), hi = bfhi(w[q]); a[2 * q] += lo * lo; a[2 * q + 1] += hi * hi; } }
#pragma unroll
        for (int e = 0; e < 8; ++e) red[F.wave * 512 + 8 * F.lane + e] = a[e];
        __syncthreads();
        { float s = 0.f;
#pragma unroll
          for (int w = 0; w < 8; ++w) s += red[w * 512 + F.tid];
          SSP[(size_t)cb * T + tb * 512 + F.tid] = s; }
        __syncthreads();
    }
}
__device__ __forceinline__ void spatial_phase(Frame& F, int a) {
    const bf16* Wc = (const bf16*)(F.ws + WS_WSB) + (size_t)a * 16 * 128 * 128; const float* vgain = in_ptr(F, 10) + a * SGW; const float* bs = in_ptr(F, 12) + a * 16 * 128;
    const bf16* VT = (const bf16*)(F.ws + WS_VT); const bf16* U = (const bf16*)(F.ws + WS_U); bf16* US = (bf16*)(F.ws + WS_US); const float* SSP = (const float*)(F.ws + WS_SSP);
    LAS float* rsl = (LAS float*)F.lds;
    const int wr = F.wave >> 2, wc = F.wave & 3, fr = F.lane & 15, fq = F.lane >> 4;
    for (int unit = F.vcu; unit < 64 * 16; unit += F.G) {
        const int n = unit >> 4, g = unit & 15;
        __syncthreads();
        if (F.tid < 128) { float ss = 0.f;
#pragma unroll 8
            for (int cb = 0; cb < 32; ++cb) ss += SSP[(size_t)cb * T + n * 128 + F.tid];
            rsl[F.tid] = 1.0f / sqrtf(ss * (1.0f / SGW) + EPS); }
        __syncthreads();
        f32x4 acc[4][4];
#pragma unroll
        for (int mi = 0; mi < 4; ++mi)
#pragma unroll
            for (int ni = 0; ni < 4; ++ni) acc[mi][ni] = (f32x4){0.f, 0.f, 0.f, 0.f};
#pragma unroll
        for (int ks = 0; ks < 4; ++ks) {
            if (ks * 32 > wr * 64 + 63) continue;
            float rs[8];
#pragma unroll
            for (int j = 0; j < 8; ++j) rs[j] = rsl[ks * 32 + 8 * fq + j];
            bf16x8 af[4], bfr[4];
#pragma unroll
            for (int mi = 0; mi < 4; ++mi) { const v4u w = *(const GAS v4u*)(Wc + ((size_t)(g * 128 + wr * 64 + mi * 16 + fr) * 128 + ks * 32 + 8 * fq));
                v4u o; o.x = pk2(bflo(w.x) * rs[0], bfhi(w.x) * rs[1]); o.y = pk2(bflo(w.y) * rs[2], bfhi(w.y) * rs[3]); o.z = pk2(bflo(w.z) * rs[4], bfhi(w.z) * rs[5]); o.w = pk2(bflo(w.w) * rs[6], bfhi(w.w) * rs[7]);
                af[mi] = __builtin_bit_cast(bf16x8, o); }
#pragma unroll
            for (int ni = 0; ni < 4; ++ni) bfr[ni] = *(const GAS bf16x8*)(VT + (size_t)(g * 256 + wc * 64 + ni * 16 + fr) * T + n * 128 + ks * 32 + 8 * fq);
#pragma unroll
            for (int mi = 0; mi < 4; ++mi)
#pragma unroll
                for (int ni = 0; ni < 4; ++ni) acc[mi][ni] = __builtin_amdgcn_mfma_f32_16x16x32_bf16(bfr[ni], af[mi], acc[mi][ni], 0, 0, 0);
        }
#pragma unroll
        for (int mi = 0; mi < 4; ++mi) { const int t = wr * 64 + mi * 16 + fr; const float bt = bs[g * 128 + t]; const size_t ro = (size_t)(n * 128 + t) * SGW;
#pragma unroll
            for (int ni = 0; ni < 4; ++ni) { const int cc = g * 256 + wc * 64 + ni * 16 + 4 * fq;
                const v2u uu = *(const GAS v2u*)(U + ro + cc); const f32x4 gv = *(const GAS f32x4*)(vgain + cc); const f32x4 val = acc[mi][ni] * gv + bt;
                v2u o; o.x = pk2(bflo(uu.x) * val.x, bfhi(uu.x) * val.y); o.y = pk2(bflo(uu.y) * val.z, bfhi(uu.y) * val.w);
                *(GAS v2u*)(US + ro + cc) = o; } }
    }
}

__device__ __forceinline__ void convgate_phase(Frame& F, int layer) {
    const bf16* Z = (const bf16*)(F.ws + WS_Z); bf16* Gb = (bf16*)(F.ws + WS_G);
    const float* cw = in_ptr(F, 6) + (size_t)layer * 3 * DFF2; const float* cbv = in_ptr(F, 7) + (size_t)layer * DFF2;
    const int gw = F.vcu * NWAVES + F.wave, NGW = F.G * NWAVES;
    for (int it = gw; it < 11 * 256; it += NGW) {
        const int cc = it % 11, rc = it / 11; const int j0 = cc * 512 + 8 * F.lane, t0 = rc * 32;
        float wa[3][8], wv[3][8], ba[8], bv[8];
#pragma unroll
        for (int k = 0; k < 3; ++k)
#pragma unroll
            for (int e = 0; e < 8; ++e) { wa[k][e] = cw[k * DFF2 + j0 + e]; wv[k][e] = cw[k * DFF2 + DFF + j0 + e]; }
#pragma unroll
        for (int e = 0; e < 8; ++e) { ba[e] = cbv[j0 + e]; bv[e] = cbv[DFF + j0 + e]; }
        float a1[8], a2[8], v1[8], v2[8];
#pragma unroll
        for (int e = 0; e < 8; ++e) { a1[e] = 0.f; a2[e] = 0.f; v1[e] = 0.f; v2[e] = 0.f; }
        if (t0 > 0) {
            const v4u pa1 = *(const GAS v4u*)(Z + (size_t)(t0 - 1) * DFF2 + j0), pa2 = *(const GAS v4u*)(Z + (size_t)(t0 - 2) * DFF2 + j0);
            const v4u pv1 = *(const GAS v4u*)(Z + (size_t)(t0 - 1) * DFF2 + DFF + j0), pv2 = *(const GAS v4u*)(Z + (size_t)(t0 - 2) * DFF2 + DFF + j0);
            const unsigned xa1[4] = {pa1.x, pa1.y, pa1.z, pa1.w}, xa2[4] = {pa2.x, pa2.y, pa2.z, pa2.w}, xv1[4] = {pv1.x, pv1.y, pv1.z, pv1.w}, xv2[4] = {pv2.x, pv2.y, pv2.z, pv2.w};
#pragma unroll
            for (int q = 0; q < 4; ++q) { a1[2 * q] = bflo(xa1[q]); a1[2 * q + 1] = bfhi(xa1[q]); a2[2 * q] = bflo(xa2[q]); a2[2 * q + 1] = bfhi(xa2[q]);
                v1[2 * q] = bflo(xv1[q]); v1[2 * q + 1] = bfhi(xv1[q]); v2[2 * q] = bflo(xv2[q]); v2[2 * q + 1] = bfhi(xv2[q]); }
        }
#pragma unroll 2
        for (int t = t0; t < t0 + 32; ++t) {
            const v4u pa = *(const GAS v4u*)(Z + (size_t)t * DFF2 + j0), pv = *(const GAS v4u*)(Z + (size_t)t * DFF2 + DFF + j0);
            const unsigned xa[4] = {pa.x, pa.y, pa.z, pa.w}, xv[4] = {pv.x, pv.y, pv.z, pv.w};
            float a0[8], v0[8], o[8];
#pragma unroll
            for (int q = 0; q < 4; ++q) { a0[2 * q] = bflo(xa[q]); a0[2 * q + 1] = bfhi(xa[q]); v0[2 * q] = bflo(xv[q]); v0[2 * q + 1] = bfhi(xv[q]); }
#pragma unroll
            for (int e = 0; e < 8; ++e) { const float av = ba[e] + wa[0][e] * a2[e] + wa[1][e] * a1[e] + wa[2][e] * a0[e]; const float vv = bv[e] + wv[0][e] * v2[e] + wv[1][e] * v1[e] + wv[2][e] * v0[e];
                o[e] = silu_f(av) * vv; a2[e] = a1[e]; a1[e] = a0[e]; v2[e] = v1[e]; v1[e] = v0[e]; }
            v4u w; w.x = pk2(o[0], o[1]); w.y = pk2(o[2], o[3]); w.z = pk2(o[4], o[5]); w.w = pk2(o[6], o[7]);
            *(GAS v4u*)(Gb + (size_t)t * DFF + j0) = w;
        }
    }
}

constexpr int CP_RED = 0, CP_H1 = 65536, CP_SSP = CP_H1 + 16 * 136 * 2, CP_END = CP_SSP + 8 * 16 * 4;
static_assert(CP_END <= RING_BYTES, "compress LDS");
__device__ __forceinline__ void kvpost_phase(Frame& F) {
    bf16* KV = (bf16*)(F.ws + WS_KV); const float* kg = in_ptr(F, 21);
    const int gw = F.vcu * NWAVES + F.wave, NGW = F.G * NWAVES;
    const int lane = F.lane, fr = lane & 15, fq = lane >> 4, w = F.wave;
    for (int t = gw; t < T; t += NGW) {
#pragma unroll
        for (int q = 0; q < 2; ++q) { const int tensor = q ? 4 : 2; bf16* p = KV + (size_t)t * NKVC + tensor * 512 + 8 * lane;
            const v4u v = *(const GAS v4u*)p; const unsigned wv[4] = {v.x, v.y, v.z, v.w}; float x[8]; float ss = 0.f;
#pragma unroll
            for (int e = 0; e < 4; ++e) { x[2 * e] = bflo(wv[e]); x[2 * e + 1] = bfhi(wv[e]); ss += x[2 * e] * x[2 * e] + x[2 * e + 1] * x[2 * e + 1]; }
            ss += __shfl_xor(ss, 1); ss += __shfl_xor(ss, 2); ss += __shfl_xor(ss, 4); ss += __shfl_xor(ss, 8);
            const float rs = 1.0f / sqrtf(ss * (1.0f / HD) + EPS); const float* gp = kg + (q ? 2 : 1) * HD + ((8 * lane) & 127);
            v4u o; o.x = pk2(x[0] * rs * gp[0], x[1] * rs * gp[1]); o.y = pk2(x[2] * rs * gp[2], x[3] * rs * gp[3]); o.z = pk2(x[4] * rs * gp[4], x[5] * rs * gp[5]); o.w = pk2(x[6] * rs * gp[6], x[7] * rs * gp[7]);
            *(GAS v4u*)p = o; }
    }
    const float* posb = (const float*)(F.ws + WS_POSB);
    LAS f32x4* red = (LAS f32x4*)(F.lds + CP_RED); LAS bf16* h1 = (LAS bf16*)(F.lds + CP_H1); LAS float* ssp = (LAS float*)(F.lds + CP_SSP);
    for (int it = F.vcu; it < 256; it += F.G) {
        const int i = it >> 7, g = (it >> 5) & 3, n0 = (it & 31) * 16;
        const bf16* W1T = (const bf16*)(F.ws + WS_W1T) + (size_t)i * 128 * 4096; const bf16* W2T = (const bf16*)(F.ws + WS_W2T) + (size_t)i * 128 * 128;
        int nrow = n0 + fr; if (nrow > NCMP - 1) nrow = NCMP - 1;
        f32x4 acc[8];
#pragma unroll
        for (int ni = 0; ni < 8; ++ni) acc[ni] = (f32x4){0.f, 0.f, 0.f, 0.f};
#pragma unroll 2
        for (int ks = 0; ks < 16; ++ks) { const int l = 4 * w + (ks >> 2), d0 = (ks & 3) * 32;
            const bf16x8 a = *(const GAS bf16x8*)(KV + (size_t)(16 * nrow + l) * NKVC + i * 512 + g * 128 + d0 + 8 * fq);
            bf16x8 b[8];
#pragma unroll
            for (int ni = 0; ni < 8; ++ni) b[ni] = *(const GAS bf16x8*)(W1T + (size_t)(ni * 16 + fr) * 4096 + (16 * w + ks) * 32 + 8 * fq);
#pragma unroll
            for (int ni = 0; ni < 8; ++ni) acc[ni] = __builtin_amdgcn_mfma_f32_16x16x32_bf16(a, b[ni], acc[ni], 0, 0, 0); }
#pragma unroll
        for (int ni = 0; ni < 8; ++ni) red[(w * 8 + ni) * 64 + lane] = acc[ni];
        __syncthreads();
        { const int e = F.tid, ni = e >> 6, l2 = e & 63; f32x4 v = red[ni * 64 + l2];
#pragma unroll
          for (int ww = 1; ww < 8; ++ww) v += red[(ww * 8 + ni) * 64 + l2];
          const int col = ni * 16 + (l2 & 15); const float pb = posb[i * 128 + col];
#pragma unroll
          for (int q = 0; q < 4; ++q) h1[(4 * (l2 >> 4) + q) * 136 + col] = (bf16)f2bf(pg8::gelu_tanh(v[q] + pb)); }
        __syncthreads();
        f32x4 acc2 = (f32x4){0.f, 0.f, 0.f, 0.f};
#pragma unroll
        for (int k2 = 0; k2 < 4; ++k2) { const bf16x8 a = *(const LAS bf16x8*)(h1 + fr * 136 + k2 * 32 + 8 * fq); const bf16x8 b = *(const GAS bf16x8*)(W2T + (size_t)(16 * w + fr) * 128 + k2 * 32 + 8 * fq);
            acc2 = __builtin_amdgcn_mfma_f32_16x16x32_bf16(a, b, acc2, 0, 0, 0); }
        if (i == 0) {
            float sq[4];
#pragma unroll
            for (int q = 0; q < 4; ++q) { float s = acc2[q] * acc2[q]; s += __shfl_xor(s, 1); s += __shfl_xor(s, 2); s += __shfl_xor(s, 4); s += __shfl_xor(s, 8); sq[q] = s; }
            if (fr == 0) {
#pragma unroll
                for (int q = 0; q < 4; ++q) ssp[w * 16 + 4 * fq + q] = sq[q]; }
            __syncthreads();
#pragma unroll
            for (int q = 0; q < 4; ++q) { float s = 0.f;
#pragma unroll
                for (int ww = 0; ww < 8; ++ww) s += ssp[ww * 16 + 4 * fq + q];
                acc2[q] *= (1.0f / sqrtf(s * (1.0f / HD) + EPS)) * kg[16 * w + fr]; }
        }
        bf16* dst = (bf16*)(F.ws + (i ? WS_VC : WS_KC)) + (size_t)(g * 512) * HD;
#pragma unroll
        for (int q = 0; q < 4; ++q) { const int n = n0 + 4 * fq + q; dst[(size_t)n * HD + 16 * w + fr] = (n < NCMP) ? (bf16)f2bf(acc2[q]) : (bf16)0; }
        __syncthreads();
    }
}

__device__ __forceinline__ void gates_phase(Frame& F, int bl) {
    const bf16* H = (const bf16*)(F.ws + WS_H); float* GT = (float*)(F.ws + WS_GATES); const bf16* WGT = (const bf16*)(F.ws + WS_WGT) + (size_t)bl * 48 * D;
    const int lane = F.lane, fr = lane & 15, fq = lane >> 4, w = F.wave;
    LAS f32x4* red = (LAS f32x4*)(F.lds);
    for (int it = F.vcu; it < T / 32; it += F.G) {
        const int r0 = it * 32;
        f32x4 acc[2][3];
#pragma unroll
        for (int mi = 0; mi < 2; ++mi)
#pragma unroll
            for (int ni = 0; ni < 3; ++ni) acc[mi][ni] = (f32x4){0.f, 0.f, 0.f, 0.f};
#pragma unroll 4
        for (int ks = 0; ks < 8; ++ks) { const int k = 256 * w + ks * 32 + 8 * fq; bf16x8 a[2], b[3];
#pragma unroll
            for (int mi = 0; mi < 2; ++mi) a[mi] = *(const GAS bf16x8*)(H + (size_t)(r0 + mi * 16 + fr) * D + k);
#pragma unroll
            for (int ni = 0; ni < 3; ++ni) b[ni] = *(const GAS bf16x8*)(WGT + (size_t)(ni * 16 + fr) * D + k);
#pragma unroll
            for (int mi = 0; mi < 2; ++mi)
#pragma unroll
                for (int ni = 0; ni < 3; ++ni) acc[mi][ni] = __builtin_amdgcn_mfma_f32_16x16x32_bf16(a[mi], b[ni], acc[mi][ni], 0, 0, 0); }
#pragma unroll
        for (int mi = 0; mi < 2; ++mi)
#pragma unroll
            for (int ni = 0; ni < 3; ++ni) red[((w * 2 + mi) * 3 + ni) * 64 + lane] = acc[mi][ni];
        __syncthreads();
        if (F.tid < 384) { const int e = F.tid, mn = e >> 6, l2 = e & 63, mi = mn / 3, ni = mn - 3 * mi; f32x4 v = red[mn * 64 + l2];
#pragma unroll
            for (int ww = 1; ww < 8; ++ww) v += red[(ww * 6 + mn) * 64 + l2];
#pragma unroll
            for (int q = 0; q < 4; ++q) GT[(size_t)(r0 + mi * 16 + 4 * (l2 >> 4) + q) * 48 + ni * 16 + (l2 & 15)] = sigmoid_f(v[q]); }
        __syncthreads();
    }
}

constexpr int AN_QS = 0, AN_SC = 2048, AN_RI = AN_SC + 8192, AN_IMP = AN_RI + 2048, AN_SEL = AN_IMP + 512, AN_WSL = 13312;
struct AttnState { float m[4], l[4], o[4][2]; };
template <class KeyMap>
__device__ __forceinline__ void attn_chunk(Frame& F, LAS unsigned char* wl, const bf16* Kb, const bf16* Vb, int rstride, int nk, const KeyMap& km, const float (&slope)[4], AttnState& st) {
    LAS float* qs = (LAS float*)(wl + AN_QS); LAS float* sc = (LAS float*)(wl + AN_SC); LAS int* ri = (LAS int*)(wl + AN_RI);
    const int lane = F.lane;
    for (int j = lane; j < nk; j += 64) {
        int row, dist; km(j, row, dist);
        ri[j] = row;
        float a[4] = {0.f, 0.f, 0.f, 0.f};
        if (dist >= 0) {
            const bf16* kp = Kb + (size_t)row * rstride;
#pragma unroll 4
            for (int c = 0; c < 16; ++c) { const v4u v = *(const GAS v4u*)(kp + 8 * c); const unsigned w[4] = {v.x, v.y, v.z, v.w}; float x[8];
#pragma unroll
                for (int e = 0; e < 4; ++e) { x[2 * e] = bflo(w[e]); x[2 * e + 1] = bfhi(w[e]); }
#pragma unroll
                for (int r = 0; r < 4; ++r) { const f32x4 q0 = *(const LAS f32x4*)(qs + r * 128 + 8 * c), q1 = *(const LAS f32x4*)(qs + r * 128 + 8 * c + 4);
                    a[r] += (x[0] * q0.x + x[1] * q0.y) + (x[2] * q0.z + x[3] * q0.w) + (x[4] * q1.x + x[5] * q1.y) + (x[6] * q1.z + x[7] * q1.w); } }
        }
#pragma unroll
        for (int r = 0; r < 4; ++r) sc[r * 512 + j] = dist >= 0 ? a[r] - slope[r] * (float)dist : NEGBIG;
    }
    LDS_WAIT(); asm volatile("" ::: "memory");
#pragma unroll
    for (int r = 0; r < 4; ++r) {
        float cm = NEGBIG;
        for (int j = lane; j < nk; j += 64) cm = fmaxf(cm, sc[r * 512 + j]);
        cm = wave_max(cm);
        const float mn = fmaxf(st.m[r], cm);
        const float alpha = __expf(st.m[r] - mn);
        float ps = 0.f;
        for (int j = lane; j < nk; j += 64) { const float s = sc[r * 512 + j]; const float p = s > -1e29f ? __expf(s - mn) : 0.f; sc[r * 512 + j] = p; ps += p; }
        ps = wave_sum(ps);
        st.l[r] = st.l[r] * alpha + ps; st.o[r][0] *= alpha; st.o[r][1] *= alpha; st.m[r] = mn;
    }
    LDS_WAIT(); asm volatile("" ::: "memory");
    for (int j = 0; j < nk; ++j) {
        const int row = ri[j];
        const unsigned vv = *(const GAS unsigned*)(Vb + (size_t)row * rstride + 2 * lane); const float v0 = bflo(vv), v1 = bfhi(vv);
#pragma unroll
        for (int r = 0; r < 4; ++r) { const float p = sc[r * 512 + j]; st.o[r][0] += p * v0; st.o[r][1] += p * v1; }
    }
    LDS_WAIT(); asm volatile("" ::: "memory");
}
struct KmCmp { int t; __device__ __forceinline__ void operator()(int j, int& row, int& dist) const { row = j; dist = t - (16 * j + 31); } };
struct KmSlc { int t; const LAS int* sel; int base; __device__ __forceinline__ void operator()(int j, int& row, int& dist) const { const int b = sel[base + (j >> 6)]; const int p = 64 * b + (j & 63); row = p; dist = t - p; } };
struct KmWin { int t; int p0; __device__ __forceinline__ void operator()(int j, int& row, int& dist) const { const int p = p0 + j; row = p; dist = t - p; } };

__device__ __forceinline__ void attn_naive_phase(Frame& F, int bl) {
    const bf16* Q = (const bf16*)(F.ws + WS_Q); const bf16* KV = (const bf16*)(F.ws + WS_KV); const bf16* KC = (const bf16*)(F.ws + WS_KC); const bf16* VC = (const bf16*)(F.ws + WS_VC);
    const float* GT = (const float*)(F.ws + WS_GATES); bf16* ATT = (bf16*)(F.ws + WS_ATT); const float* qg = in_ptr(F, 23) + bl * HD;
    const int gw = F.vcu * NWAVES + F.wave, NGW = F.G * NWAVES; const int lane = F.lane;
    LAS unsigned char* wl = F.lds + F.wave * AN_WSL;
    LAS float* qs = (LAS float*)(wl + AN_QS); LAS float* sc = (LAS float*)(wl + AN_SC); LAS float* imp = (LAS float*)(wl + AN_IMP); LAS int* sel = (LAS int*)(wl + AN_SEL);
    const float qscale = 0.08838834764831845f;
    for (int item = gw; item < T * 4; item += NGW) {
        const int t = item >> 2, g = item & 3;
        float slope[4];
#pragma unroll
        for (int r = 0; r < 4; ++r) {
            slope[r] = __builtin_amdgcn_exp2f(-0.5f * (float)(g * 4 + r + 1));
            const unsigned w = *(const GAS unsigned*)(Q + (size_t)t * D + (g * 4 + r) * HD + 2 * lane); const float q0 = bflo(w), q1 = bfhi(w);
            const float ss = wave_sum(q0 * q0 + q1 * q1); const float rs = 1.0f / sqrtf(ss * (1.0f / HD) + EPS) * qscale;
            qs[r * 128 + 2 * lane] = q0 * rs * qg[2 * lane]; qs[r * 128 + 2 * lane + 1] = q1 * rs * qg[2 * lane + 1]; }
        LDS_WAIT(); asm volatile("" ::: "memory");
        float outv[4][2];
        { int nv = t >= 31 ? ((t - 31) >> 4) + 1 : 0; if (nv > NCMP) nv = NCMP;
          AttnState st;
#pragma unroll
          for (int r = 0; r < 4; ++r) { st.m[r] = NEGBIG; st.l[r] = 0.f; st.o[r][0] = 0.f; st.o[r][1] = 0.f; }
          imp[lane] = 0.f; imp[64 + lane] = 0.f;
          if (nv > 0) {
              KmCmp km{t};
              attn_chunk(F, wl, KC + (size_t)g * 512 * HD, VC + (size_t)g * 512 * HD, HD, nv, km, slope, st);
              float inv[4];
#pragma unroll
              for (int r = 0; r < 4; ++r) inv[r] = 1.0f / fmaxf(st.l[r], 1e-30f);
#pragma unroll
              for (int h = 0; h < 2; ++h) { const int s = lane + 64 * h; float a = 0.f;
                  for (int n = 4 * s - 1; n <= 4 * s + 3; ++n) if (n >= 0 && n < nv) { a += sc[n] * inv[0] + sc[512 + n] * inv[1] + sc[1024 + n] * inv[2] + sc[1536 + n] * inv[3]; }
                  imp[s] = a; }
          }
          LDS_WAIT(); asm volatile("" ::: "memory");
#pragma unroll
          for (int r = 0; r < 4; ++r) { const float gt = GT[(size_t)t * 48 + 0 * 16 + g * 4 + r]; const float inv = 1.0f / fmaxf(st.l[r], 1e-30f); outv[r][0] = gt * st.o[r][0] * inv; outv[r][1] = gt * st.o[r][1] * inv; }
        }
        const int cur = t >> 6; int nsel;
        if (cur < 16) { nsel = cur + 1; if (lane < 16) sel[lane] = lane; }
        else {
            nsel = 16;
            float v0 = imp[lane], v1 = imp[64 + lane];
            { const int s0 = lane, s1 = lane + 64; if (s0 < 1 || s0 > cur - 2) v0 = -1.f; if (s1 > cur - 2) v1 = -1.f; }
            if (lane == 0) { sel[0] = 0; sel[1] = cur; sel[2] = cur - 1; }
            for (int k = 0; k < 13; ++k) {
                const float mx = wave_max(fmaxf(v0, v1));
                const unsigned long long b0 = __ballot(v0 == mx), b1 = __ballot(v1 == mx);
                const int idx = b0 ? (int)__builtin_ctzll(b0) : 64 + (int)__builtin_ctzll(b1);
                if (lane == 0) sel[3 + k] = idx;
                if (idx == lane) v0 = -1.f; if (idx == lane + 64) v1 = -1.f;
            }
        }
        LDS_WAIT(); asm volatile("" ::: "memory");
        { AttnState st;
#pragma unroll
          for (int r = 0; r < 4; ++r) { st.m[r] = NEGBIG; st.l[r] = 0.f; st.o[r][0] = 0.f; st.o[r][1] = 0.f; }
          for (int c0 = 0; c0 < nsel; c0 += 8) { const int nb = (nsel - c0) < 8 ? (nsel - c0) : 8; KmSlc km{t, sel, c0};
              attn_chunk(F, wl, KV + 2 * 512 + g * HD, KV + 3 * 512 + g * HD, NKVC, nb * 64, km, slope, st); }
#pragma unroll
          for (int r = 0; r < 4; ++r) { const float gt = GT[(size_t)t * 48 + 1 * 16 + g * 4 + r]; const float inv = 1.0f / fmaxf(st.l[r], 1e-30f); outv[r][0] += gt * st.o[r][0] * inv; outv[r][1] += gt * st.o[r][1] * inv; }
        }
        { AttnState st;
#pragma unroll
          for (int r = 0; r < 4; ++r) { st.m[r] = NEGBIG; st.l[r] = 0.f; st.o[r][0] = 0.f; st.o[r][1] = 0.f; }
          const int p0 = t - (WIN - 1) > 0 ? t - (WIN - 1) : 0; KmWin km{t, p0};
          attn_chunk(F, wl, KV + 4 * 512 + g * HD, KV + 5 * 512 + g * HD, NKVC, t - p0 + 1, km, slope, st);
#pragma unroll
          for (int r = 0; r < 4; ++r) { const float gt = GT[(size_t)t * 48 + 2 * 16 + g * 4 + r]; const float inv = 1.0f / fmaxf(st.l[r], 1e-30f); outv[r][0] += gt * st.o[r][0] * inv; outv[r][1] += gt * st.o[r][1] * inv; }
        }
#pragma unroll
        for (int r = 0; r < 4; ++r) *(GAS unsigned*)(ATT + (size_t)t * D + (g * 4 + r) * HD + 2 * lane) = pk2(outv[r][0], outv[r][1]);
    }
}

namespace att {
typedef short s16x4 __attribute__((ext_vector_type(4)));
typedef float f32x16 __attribute__((ext_vector_type(16)));
typedef unsigned u32x4 __attribute__((ext_vector_type(4)));
constexpr int SHM_K = 16384, SHM_V = 16384;
constexpr int L_K = 0, L_V = 32768, L_IMP = 65536, IMP_STRIDE = 132, L_WS = L_IMP + 8 * 8 * IMP_STRIDE * 4, L_UN = L_WS + 8 * 256, L_END = L_UN + 128;
static_assert(L_END <= RING_BYTES, "attention LDS");
constexpr float THR = 8.0f;
#define KSWZ(row, colB) ((row) * 256 + ((colB) ^ (((row) & 7) << 4)))
#define SBAR() __builtin_amdgcn_sched_barrier(0)
__device__ __forceinline__ int v_st(int k, int c) { const int kk = (k & ~0xC) | ((k & 4) << 1) | ((k & 8) >> 1); return ((kk >> 3) * 4 + (c >> 5)) * 512 + ((kk & 7) * 32 + (c & 31)) * 2; }
__device__ __forceinline__ int v_rd_base(int lane) { return ((lane & 3) << 3) | (((lane >> 2) & 3) << 6) | (((lane >> 4) & 1) << 5) | (((lane >> 5) & 1) << 8); }
constexpr int v_rd_off(int d0, int ks, int half) { return d0 * 512 + ks * 4096 + half * 2048; }
__device__ __forceinline__ int crow(int r, int hi) { return (r & 3) + 8 * (r >> 2) + 4 * hi; }
__device__ __forceinline__ unsigned cvtpk(float lo, float hi) { unsigned r; asm volatile("v_cvt_pk_bf16_f32 %0, %1, %2" : "=v"(r) : "v"(lo), "v"(hi)); return r; }

template <int STRIDE, bool MASKED>
__device__ __forceinline__ void init_p(f32x16& p0, f32x16& p1, float nb, float slope2, int dq, unsigned W) {
    const float NEG = -__builtin_inff();
#pragma unroll
    for (int r = 0; r < 16; ++r) {
        const int c = ((r & 3) + 8 * (r >> 2)) * STRIDE;
        float v0 = fmaf(slope2, (float)c, nb), v1 = fmaf(slope2, (float)(c + 32 * STRIDE), nb);
        if (MASKED) { if ((unsigned)(dq - c) >= W) v0 = NEG; if ((unsigned)(dq - c - 32 * STRIDE) >= W) v1 = NEG; }
        p0[r] = v0; p1[r] = v1;
    }
}
__device__ __forceinline__ void qkt(f32x16& p0, f32x16& p1, const LAS unsigned char* kt, int r32, int hi, const bf16x8 (&qr)[8]) {
    const LAS unsigned char* kb[4];
#pragma unroll
    for (int dd = 0; dd < 4; ++dd) kb[dd] = kt + KSWZ(r32, (dd * 16 + hi * 8) * 2);
#pragma unroll
    for (int d0 = 0; d0 < 8; ++d0) { const LAS unsigned char* a = kb[d0 & 3] + (d0 >> 2) * 128;
        const bf16x8 b0 = *(const LAS bf16x8*)a;
        const bf16x8 b1 = *(const LAS bf16x8*)(a + 32 * 256);
        p0 = __builtin_amdgcn_mfma_f32_32x32x16_bf16(b0, qr[d0], p0, 0, 0, 0);
        p1 = __builtin_amdgcn_mfma_f32_32x32x16_bf16(b1, qr[d0], p1, 0, 0, 0); if (d0 & 1) SBAR(); }
}
__device__ __forceinline__ void pv_tile(f32x16 (&o)[4], int vb, bf16x8 pa0, bf16x8 pa1, bf16x8 pa2, bf16x8 pa3) {
#define TRRD(dst, off) asm volatile("ds_read_b64_tr_b16 %0, %1 offset:%2" : "=&v"(dst) : "v"(vb), "i"(off) : "memory")
#define PV_D0(d0) do { { s16x4 l0, l1, h0, h1; constexpr int b_ = v_rd_off(d0, 0, 0); \
        TRRD(l0, b_); TRRD(h0, b_ + 2048); TRRD(l1, b_ + 4096); TRRD(h1, b_ + 6144); \
        asm volatile("s_waitcnt lgkmcnt(0)" ::: "memory"); SBAR(); \
        o[d0] = __builtin_amdgcn_mfma_f32_32x32x16_bf16(pa0, (bf16x8){l0[0], l0[1], l0[2], l0[3], h0[0], h0[1], h0[2], h0[3]}, o[d0], 0, 0, 0); \
        o[d0] = __builtin_amdgcn_mfma_f32_32x32x16_bf16(pa1, (bf16x8){l1[0], l1[1], l1[2], l1[3], h1[0], h1[1], h1[2], h1[3]}, o[d0], 0, 0, 0); } \
      { s16x4 l2, l3, h2, h3; constexpr int b_ = v_rd_off(d0, 0, 0); \
        TRRD(l2, b_ + 8192); TRRD(h2, b_ + 10240); TRRD(l3, b_ + 12288); TRRD(h3, b_ + 14336); \
        asm volatile("s_waitcnt lgkmcnt(0)" ::: "memory"); SBAR(); \
        o[d0] = __builtin_amdgcn_mfma_f32_32x32x16_bf16(pa2, (bf16x8){l2[0], l2[1], l2[2], l2[3], h2[0], h2[1], h2[2], h2[3]}, o[d0], 0, 0, 0); \
        o[d0] = __builtin_amdgcn_mfma_f32_32x32x16_bf16(pa3, (bf16x8){l3[0], l3[1], l3[2], l3[3], h3[0], h3[1], h3[2], h3[3]}, o[d0], 0, 0, 0); } } while (0)
    PV_D0(0); PV_D0(1); PV_D0(2); PV_D0(3);
#undef PV_D0
#undef TRRD
}
__device__ __forceinline__ float swap_max(float v) { auto rr = __builtin_amdgcn_permlane32_swap(__float_as_uint(v), __float_as_uint(v), false, false); return fmaxf(__uint_as_float(rr[0]), __uint_as_float(rr[1])); }
__device__ __forceinline__ float swap_sum(float v) { auto rr = __builtin_amdgcn_permlane32_swap(__float_as_uint(v), __float_as_uint(v), false, false); return __uint_as_float(rr[0]) + __uint_as_float(rr[1]); }
__device__ __forceinline__ float softmax_tile(f32x16& p0, f32x16& p1, float& m_reg, float& l_reg, bf16x8& pa0, bf16x8& pa1, bf16x8& pa2, bf16x8& pa3) {
    float pmax = p0[0];
#pragma unroll
    for (int r = 1; r < 16; ++r) pmax = fmaxf(pmax, p0[r]);
#pragma unroll
    for (int r = 0; r < 16; ++r) pmax = fmaxf(pmax, p1[r]);
    pmax = swap_max(pmax);
    float mn, alpha;
    if (__all((pmax - m_reg) <= THR)) { mn = m_reg; alpha = 1.f; }
    else { mn = fmaxf(m_reg, pmax); alpha = __builtin_amdgcn_exp2f(m_reg - mn); m_reg = mn; }
#pragma unroll
    for (int r = 0; r < 16; ++r) { p0[r] = __builtin_amdgcn_exp2f(p0[r] - mn); p1[r] = __builtin_amdgcn_exp2f(p1[r] - mn); }
    float ps = 0.f;
#pragma unroll
    for (int r = 0; r < 16; ++r) ps += p0[r] + p1[r];
    ps = swap_sum(ps);
    l_reg = l_reg * alpha + ps;
#define PK4(P, B_, OUT) do { unsigned a0 = cvtpk(P[B_+0], P[B_+1]), a1 = cvtpk(P[B_+2], P[B_+3]); \
        unsigned b0 = cvtpk(P[B_+4], P[B_+5]), b1 = cvtpk(P[B_+6], P[B_+7]); \
        auto r0 = __builtin_amdgcn_permlane32_swap(a0, b0, false, false); auto r1 = __builtin_amdgcn_permlane32_swap(a1, b1, false, false); \
        u32x4 w = {r0[0], r1[0], r0[1], r1[1]}; OUT = __builtin_bit_cast(bf16x8, w); } while (0)
    PK4(p0, 0, pa0); PK4(p0, 8, pa1); PK4(p1, 0, pa2); PK4(p1, 8, pa3);
#undef PK4
    return alpha;
}
__device__ __forceinline__ int next_bit(unsigned long long u0, unsigned long long u1, int from) {
    if (from < 64) { const unsigned long long m = u0 & (~0ull << from); if (m) return (int)__builtin_ctzll(m); from = 64; }
    if (from < 128) { const unsigned long long m = u1 & (~0ull << (from - 64)); if (m) return 64 + (int)__builtin_ctzll(m); }
    return 128;
}
__device__ __forceinline__ bool bit128(unsigned long long u0, unsigned long long u1, int s) { return s < 64 ? ((u0 >> s) & 1ull) != 0 : ((u1 >> (s - 64)) & 1ull) != 0; }
}

__device__ __forceinline__ void attn_unit(Frame& F, int bl, int qb, int g) {
    using namespace att;
    const bf16* Q = (const bf16*)(F.ws + WS_Q); const bf16* KV = (const bf16*)(F.ws + WS_KV); const bf16* KC = (const bf16*)(F.ws + WS_KC) + (size_t)g * 512 * HD; const bf16* VC = (const bf16*)(F.ws + WS_VC) + (size_t)g * 512 * HD;
    const float* GT = (const float*)(F.ws + WS_GATES); bf16* ATT = (bf16*)(F.ws + WS_ATT); const float* qg = in_ptr(F, 23) + bl * HD;
    int tid_ = F.tid; asm volatile("" : "+v"(tid_));
    const int tid = tid_, wid = F.wave, lane = tid & 63, r32 = lane & 31, hi = lane >> 5;
    LAS unsigned char* lds = F.lds;
    const int head = g * 4 + (r32 >> 3), qi = r32 & 7;
    const int t0 = qb * 64, t = t0 + wid * 8 + qi, cur = qb;
    const float slope2 = 1.4426950408889634f * __builtin_amdgcn_exp2f(-0.5f * (float)(head + 1));
    const int sr = tid >> 4, sc = (tid & 15) * 8; const int kws = KSWZ(sr, sc * 2), vst0 = v_st(sr, sc), vst1 = v_st(32 + sr, sc);
    const int vrb = (int)(unsigned)(size_t)(lds + L_V) + v_rd_base(lane);
    LAS float* wsf = (LAS float*)(lds + L_WS + wid * 256);
    LAS float* imp = (LAS float*)(lds + L_IMP) + wid * 8 * IMP_STRIDE;
    bf16x8 qr[8];
    { const bf16* qp = Q + (size_t)t * D + head * HD + hi * 8; float ss = 0.f;
#pragma unroll
      for (int d0 = 0; d0 < 8; ++d0) { qr[d0] = *(const GAS bf16x8*)(qp + d0 * 16); const v4u v = __builtin_bit_cast(v4u, qr[d0]); const unsigned w[4] = {v.x, v.y, v.z, v.w};
#pragma unroll
          for (int e = 0; e < 4; ++e) { const float a_ = bflo(w[e]), b_ = bfhi(w[e]); ss += a_ * a_ + b_ * b_; } }
      ss = swap_sum(ss);
      const float rs = (1.0f / sqrtf(ss * (1.0f / HD) + EPS)) * (0.08838834764831845f * 1.4426950408889634f);
#pragma unroll
      for (int d0 = 0; d0 < 8; ++d0) { const f32x4 g0 = *(const GAS f32x4*)(qg + d0 * 16 + hi * 8), g1 = *(const GAS f32x4*)(qg + d0 * 16 + hi * 8 + 4);
          const v4u v = __builtin_bit_cast(v4u, qr[d0]);
          u32x4 w; w.x = cvtpk(bflo(v.x) * rs * g0.x, bfhi(v.x) * rs * g0.y); w.y = cvtpk(bflo(v.y) * rs * g0.z, bfhi(v.y) * rs * g0.w);
          w.z = cvtpk(bflo(v.z) * rs * g1.x, bfhi(v.z) * rs * g1.y); w.w = cvtpk(bflo(v.w) * rs * g1.z, bfhi(v.w) * rs * g1.w);
          qr[d0] = __builtin_bit_cast(bf16x8, w); if (d0 & 1) SBAR(); } }
    unsigned oacc[4][8];
#pragma unroll
    for (int d0 = 0; d0 < 4; ++d0)
#pragma unroll
        for (int i = 0; i < 8; ++i) oacc[d0][i] = 0u;
    f32x16 o[4]; float m_reg, l_reg;
    bf16x8 st_k0, st_k1, st_v0, st_v1;
#define ST_LOAD(Kp, Vp, rowbase, rstride) do { const size_t o0_ = (size_t)((rowbase) + sr) * (rstride) + sc, o1_ = (size_t)((rowbase) + 32 + sr) * (rstride) + sc; \
        st_k0 = *(const GAS bf16x8*)((Kp) + o0_); st_k1 = *(const GAS bf16x8*)((Kp) + o1_); st_v0 = *(const GAS bf16x8*)((Vp) + o0_); st_v1 = *(const GAS bf16x8*)((Vp) + o1_); } while (0)
#define ST_WRITE(buf) do { *(LAS bf16x8*)(lds + L_K + (buf) * SHM_K + kws) = st_k0; *(LAS bf16x8*)(lds + L_K + (buf) * SHM_K + kws + 32 * 256) = st_k1; \
        *(LAS bf16x8*)(lds + L_V + (buf) * SHM_V + vst0) = st_v0; *(LAS bf16x8*)(lds + L_V + (buf) * SHM_V + vst1) = st_v1; } while (0)
#define BR_RESET() do { m_reg = -1e30f; l_reg = 0.f; _Pragma("unroll") for (int d_ = 0; d_ < 4; ++d_) _Pragma("unroll") for (int r_ = 0; r_ < 16; ++r_) o[d_][r_] = 0.f; } while (0)
#define RESC(a) do { if (__any((a) < 1.f)) { if (hi == 0) wsf[r32] = (a); asm volatile("s_waitcnt lgkmcnt(0)" ::: "memory"); \
        _Pragma("unroll") for (int r_ = 0; r_ < 16; ++r_) { const float al_ = wsf[crow(r_, hi)]; _Pragma("unroll") for (int d_ = 0; d_ < 4; ++d_) o[d_][r_] *= al_; } } } while (0)
#define TILE_COMPUTE(buf, STRIDE, masked, nb, dq, W) do { f32x16 p0, p1; \
        if (masked) init_p<STRIDE, true>(p0, p1, nb, slope2, dq, W); else init_p<STRIDE, false>(p0, p1, nb, slope2, dq, W); \
        qkt(p0, p1, lds + L_K + (buf) * SHM_K, r32, hi, qr); \
        bf16x8 pa0, pa1, pa2, pa3; const float al = softmax_tile(p0, p1, m_reg, l_reg, pa0, pa1, pa2, pa3); RESC(al); \
        pv_tile(o, vrb + (buf) * SHM_V, pa0, pa1, pa2, pa3); } while (0)
#define BR_FOLD(gidx) do { if (hi == 0) wsf[r32] = GT[(size_t)t * 48 + (gidx) * 16 + head] / fmaxf(l_reg, 1e-30f); asm volatile("s_waitcnt lgkmcnt(0)" ::: "memory"); \
        _Pragma("unroll") for (int i_ = 0; i_ < 8; ++i_) { const float f0_ = wsf[crow(2 * i_, hi)], f1_ = wsf[crow(2 * i_ + 1, hi)]; \
            _Pragma("unroll") for (int d_ = 0; d_ < 4; ++d_) { const unsigned w_ = oacc[d_][i_]; oacc[d_][i_] = cvtpk(bflo(w_) + o[d_][2 * i_] * f0_, bfhi(w_) + o[d_][2 * i_ + 1] * f1_); } } } while (0)

    const int NTc = (4 * qb + 3 + 63) >> 6;
    BR_RESET();
    { ST_LOAD(KC, VC, 0, HD); ST_WRITE(0); }
    __syncthreads();
    for (int j = 0; j < NTc; ++j) {
        const int buf = j & 1;
        if (j + 1 < NTc) ST_LOAD(KC, VC, (j + 1) * 64, HD);
        { const int dq = t - (16 * 64 * j + 31) - 64 * hi; const float nb = -slope2 * (float)dq;
          TILE_COMPUTE(buf, 16, true, nb, dq, 0x80000000u); }
        if (j + 1 < NTc) ST_WRITE(buf ^ 1);
        __syncthreads();
    }
    BR_FOLD(0);
    {
#pragma unroll
        for (int i = 0; i < 17; ++i) { const int idx = lane + 64 * i; if (idx < 8 * IMP_STRIDE) imp[idx] = 0.f; }
        const float invl = 1.0f / fmaxf(l_reg, 1e-30f);
        { ST_LOAD(KC, VC, 0, HD); ST_WRITE(0); }
        __syncthreads();
        for (int j = 0; j < NTc; ++j) {
            const int buf = j & 1;
            if (j + 1 < NTc) ST_LOAD(KC, VC, (j + 1) * 64, HD);
            { f32x16 p0, p1; const int dq = t - (16 * 64 * j + 31) - 64 * hi; const float nb = -slope2 * (float)dq;
              init_p<16, true>(p0, p1, nb, slope2, dq, 0x80000000u);
              qkt(p0, p1, lds + L_K + buf * SHM_K, r32, hi, qr);
#pragma unroll
              for (int hf = 0; hf < 2; ++hf)
#pragma unroll
                  for (int a = 0; a < 4; ++a) {
                      float e0, e1, e2, e3;
                      if (hf == 0) { e0 = p0[4 * a]; e1 = p0[4 * a + 1]; e2 = p0[4 * a + 2]; e3 = p0[4 * a + 3]; } else { e0 = p1[4 * a]; e1 = p1[4 * a + 1]; e2 = p1[4 * a + 2]; e3 = p1[4 * a + 3]; }
                      e0 = __builtin_amdgcn_exp2f(e0 - m_reg) * invl; e1 = __builtin_amdgcn_exp2f(e1 - m_reg) * invl; e2 = __builtin_amdgcn_exp2f(e2 - m_reg) * invl; e3 = __builtin_amdgcn_exp2f(e3 - m_reg) * invl;
                      float quad = (e0 + e1) + (e2 + e3), last = e3;
                      quad += __shfl_xor(quad, 8); quad += __shfl_xor(quad, 16); last += __shfl_xor(last, 8); last += __shfl_xor(last, 16);
                      const int s = 16 * j + 8 * hf + 2 * a + hi;
                      if (r32 < 8) { __hip_atomic_fetch_add(imp + qi * IMP_STRIDE + s, quad, __ATOMIC_RELAXED, __HIP_MEMORY_SCOPE_WORKGROUP);
                                     __hip_atomic_fetch_add(imp + qi * IMP_STRIDE + s + 1, last, __ATOMIC_RELAXED, __HIP_MEMORY_SCOPE_WORKGROUP); }
                  }
            }
            if (j + 1 < NTc) ST_WRITE(buf ^ 1);
            __syncthreads();
        }
    }
    unsigned long long wun0 = 0ull, wun1 = 0ull; LAS unsigned* wsel = (LAS unsigned*)(wsf + 32);
    asm volatile("s_waitcnt lgkmcnt(0)" ::: "memory");
    for (int q = 0; q < 8; ++q) {
        unsigned long long b0, b1;
        if (cur < 16) { b0 = (1ull << (cur + 1)) - 1ull; b1 = 0ull; }
        else {
            float v0 = imp[q * IMP_STRIDE + lane], v1 = imp[q * IMP_STRIDE + 64 + lane];
            if (lane < 1 || lane > cur - 2) v0 = -1.f;
            if (lane + 64 > cur - 2) v1 = -1.f;
            bool f0 = false, f1 = false;
            for (int k = 0; k < 13; ++k) {
                const float mx = wave_max(fmaxf(v0, v1));
                const unsigned long long e0 = __ballot(v0 == mx), e1 = __ballot(v1 == mx);
                const int idx = e0 ? (int)__builtin_ctzll(e0) : 64 + (int)__builtin_ctzll(e1);
                if (idx == lane) { v0 = -1.f; f0 = true; }
                if (idx == lane + 64) { v1 = -1.f; f1 = true; }
            }
            b0 = __ballot(f0) | 1ull; b1 = __ballot(f1);
            if (cur < 64) b0 |= 1ull << cur; else b1 |= 1ull << (cur - 64);
            if (cur - 1 < 64) b0 |= 1ull << (cur - 1); else b1 |= 1ull << (cur - 1 - 64);
        }
        if (lane == 0) { wsel[q * 4 + 0] = (unsigned)b0; wsel[q * 4 + 1] = (unsigned)(b0 >> 32); wsel[q * 4 + 2] = (unsigned)b1; wsel[q * 4 + 3] = (unsigned)(b1 >> 32); }
        wun0 |= b0; wun1 |= b1;
    }
    { LAS unsigned long long* un = (LAS unsigned long long*)(lds + L_UN);
      if (lane == 0) { un[wid * 2] = wun0; un[wid * 2 + 1] = wun1; }
      __syncthreads(); }
    unsigned long long u0 = 0ull, u1 = 0ull;
    { const LAS unsigned* un = (const LAS unsigned*)(lds + L_UN);
#pragma unroll
      for (int w = 0; w < 8; ++w) { const unsigned a0 = __builtin_amdgcn_readfirstlane(un[w * 4]), a1 = __builtin_amdgcn_readfirstlane(un[w * 4 + 1]), a2 = __builtin_amdgcn_readfirstlane(un[w * 4 + 2]), a3 = __builtin_amdgcn_readfirstlane(un[w * 4 + 3]);
          u0 |= ((unsigned long long)a1 << 32) | a0; u1 |= ((unsigned long long)a3 << 32) | a2; } }
    { const unsigned x0 = __builtin_amdgcn_readfirstlane((unsigned)wun0), x1 = __builtin_amdgcn_readfirstlane((unsigned)(wun0 >> 32)), x2 = __builtin_amdgcn_readfirstlane((unsigned)wun1), x3 = __builtin_amdgcn_readfirstlane((unsigned)(wun1 >> 32));
      wun0 = ((unsigned long long)x1 << 32) | x0; wun1 = ((unsigned long long)x3 << 32) | x2; }
    {
        const bf16* Kp = KV + 2 * 512 + g * HD; const bf16* Vp = KV + 3 * 512 + g * HD;
        BR_RESET();
        int s = next_bit(u0, u1, 0);
        { ST_LOAD(Kp, Vp, s * 64, NKVC); ST_WRITE(0); }
        __syncthreads();
        int buf = 0;
        while (s < 128) {
            const int sn = next_bit(u0, u1, s + 1);
            if (sn < 128) ST_LOAD(Kp, Vp, sn * 64, NKVC);
            if (bit128(wun0, wun1, s)) {
                const bool rowsel = ((wsel[qi * 4 + (s >> 5)] >> (s & 31)) & 1u) != 0u;
                const int dq = t - 64 * s - 4 * hi; const float nb = rowsel ? -slope2 * (float)dq : -__builtin_inff();
                const bool masked = (s == cur);
                TILE_COMPUTE(buf, 1, masked, nb, dq, 0x80000000u);
            }
            if (sn < 128) ST_WRITE(buf ^ 1);
            __syncthreads();
            buf ^= 1; s = sn;
        }
        BR_FOLD(1);
    }
    {
        const bf16* Kp = KV + 4 * 512 + g * HD; const bf16* Vp = KV + 5 * 512 + g * HD;
        BR_RESET();
        const int s_lo = cur - 8 > 0 ? cur - 8 : 0;
        { ST_LOAD(Kp, Vp, s_lo * 64, NKVC); ST_WRITE(0); }
        __syncthreads();
        int buf = 0;
        for (int s = s_lo; s <= cur; ++s) {
            if (s < cur) ST_LOAD(Kp, Vp, (s + 1) * 64, NKVC);
            { const int dq = t - 64 * s - 4 * hi; const float nb = -slope2 * (float)dq;
              const bool masked = (s == cur) || (s == cur - 8);
              TILE_COMPUTE(buf, 1, masked, nb, dq, (unsigned)WIN); }
            if (s < cur) ST_WRITE(buf ^ 1);
            __syncthreads();
            buf ^= 1;
        }
        BR_FOLD(2);
    }
    {
        LAS bf16* ot = (LAS bf16*)(lds + wid * 8192);
#pragma unroll
        for (int d0 = 0; d0 < 4; ++d0)
#pragma unroll
            for (int i = 0; i < 8; ++i) { const unsigned w = oacc[d0][i]; const int q0 = crow(2 * i, hi);
                ot[q0 * 128 + d0 * 32 + r32] = (bf16)(w & 0xffffu); ot[(q0 + 1) * 128 + d0 * 32 + r32] = (bf16)(w >> 16); }
        asm volatile("s_waitcnt lgkmcnt(0)" ::: "memory");
        int lane2 = lane; asm volatile("" : "+v"(lane2));
#pragma unroll
        for (int i = 0; i < 8; ++i) { const int idx = lane2 + 64 * i; const int q = idx >> 4, ch = idx & 15;
            const v4u v = *(const LAS v4u*)(ot + q * 128 + ch * 8);
            const int tt = t0 + wid * 8 + (q & 7), hh = g * 4 + (q >> 3);
            *(GAS v4u*)(ATT + (size_t)tt * D + hh * HD + ch * 8) = v; }
        __syncthreads();
    }
#undef ST_LOAD
#undef ST_WRITE
#undef BR_RESET
#undef RESC
#undef TILE_COMPUTE
#undef BR_FOLD
}
__device__ __forceinline__ void attn_phase(Frame& F, int bl) {
    for (int u = F.vcu; u < 256; u += F.G) {
        const int g = u & 3, qa = u >> 2;
        for (int h = 0; h < 2; ++h) attn_unit(F, bl, h ? 127 - qa : qa, g);
    }
}

struct Args { const float* in[25]; float* out; unsigned char* ws; int ph_lo, ph_hi; };
constexpr int NPHASES = 37;
__global__ void __launch_bounds__(NWAVES * 64, 2) yoco_fwd(Args args) {
    extern __shared__ __attribute__((aligned(16))) unsigned char lds[];
    Frame F;
    F.lds = (LAS unsigned char*)lds;
    F.tid = threadIdx.x; F.lane = F.tid & 63; F.wave = __builtin_amdgcn_readfirstlane(F.tid >> 6);
    F.G = gridDim.x; { const int bx = blockIdx.x; F.vcu = (F.G % 8 == 0) ? (bx % 8) * (F.G / 8) + bx / 8 : bx; }
    F.ws = args.ws;
    for (int u = F.tid; u < (LDS_BYTES - LDSCTL_OFF) / 4; u += NWAVES * 64) ((LAS unsigned*)(F.lds + LDSCTL_OFF))[u] = 0u;
    __syncthreads();
    if (F.tid < 27) { const unsigned long long pv = F.tid < 25 ? (unsigned long long)args.in[F.tid] : (F.tid == 25 ? (unsigned long long)args.out : (unsigned long long)args.ws);
        volatile LAS unsigned* p = (volatile LAS unsigned*)(F.lds + LDSCTL_OFF) + 2 * F.tid; p[0] = (unsigned)pv; p[1] = (unsigned)(pv >> 32); }
    __syncthreads();
#if MK_ONE_LAUNCH
    constexpr int lo = 0, hi = NPHASES;
#else
    const int lo = args.ph_lo, hi = args.ph_hi;
#endif
    if (hi - lo > 1) { XcdBarrier b0 = xcd_barrier_post((unsigned*)((gu32*)args.ws + CW_BAR), (volatile LAS unsigned*)(F.lds + MISC_OFF) + 8); (void)b0; }
    int pc = 0;
#define PH_BEGIN if (lo <= pc && pc < hi) { unsigned char* ws = (unsigned char*)in_ptr(F, 26); F.ws = ws; \
    { int t_ = threadIdx.x; asm volatile("" : "+v"(t_)); F.tid = t_; F.lane = t_ & 63; F.wave = __builtin_amdgcn_readfirstlane(t_ >> 6); }
#define PH_END } { const bool both_ = (lo <= pc && pc + 1 < hi); ++pc; if (both_) { XcdBarrier bar; bar.bar = (unsigned*)((gu32*)in_ptr(F, 26) + CW_BAR); bar.x = xb_xcc_id(); bar.st = (volatile LAS unsigned*)(F.lds + MISC_OFF) + 8; xcd_barrier(bar); } }
#define P_HB ((bf16*)(ws + WS_H))
#define P_HKV ((bf16*)(ws + WS_HKV))
#define P_XA ((float*)(ws + WS_XA))
#define P_XB ((float*)(ws + WS_XB))
#define P_MODS ((const float*)(ws + WS_MODS) + (size_t)layer * NMOD)
#define P_NG (in_ptr(F, 4) + (size_t)layer * 2 * D)
#define P_XIN (layer == 0 ? in_ptr(F, 0) : (const float*)P_XB)
#define P_XOUT (layer == DEPTH - 1 ? (float*)in_ptr(F, 25) : P_XB)
#define P_RING (F.lds + RING_OFF)
#ifndef REP_P0
#define REP_P0 1
#endif
#ifndef REP_ATTN
#define REP_ATTN 1
#endif
#ifndef REP_GEMM
#define REP_GEMM 1
#endif
#ifndef REP_MISC
#define REP_MISC 1
#endif
#if REP_GEMM == 2
#define GEMM_CALL(EPI, g, S, E) do { pg8::gemm_phase<EPI, pg8::StaticOrder, PG8_ALIGN, PG8_SP2>(P_RING, g, S, E, F.tid); pg8::gemm_phase<EPI, pg8::StaticOrder, PG8_ALIGN, PG8_SP2>(P_RING, g, S, E, F.tid); } while (0)
#else
#define GEMM_CALL(EPI, g, S, E) pg8::gemm_phase<EPI, pg8::StaticOrder, PG8_ALIGN, PG8_SP2>(P_RING, g, S, E, F.tid)
#endif

    PH_BEGIN for (int rep_ = 0; rep_ < REP_P0; ++rep_) { p0_prologue(F); __syncthreads(); } PH_END

    for (int layer = 0; layer < DEPTH; ++layer) {
        PH_BEGIN
            const float* mods = P_MODS;
            if (layer == NA) { const float* kvm = (const float*)(ws + WS_KVMOD); rowmod_phase<true>(F, P_XIN, P_NG, mods, mods + D, P_HB, in_ptr(F, 14), kvm, kvm + D, P_HKV); }
            else rowmod_phase<false>(F, P_XIN, P_NG, mods, mods + D, P_HB, nullptr, nullptr, nullptr, nullptr);
        PH_END
        if (layer < NA) {
            PH_BEGIN
                const bf16* Wt = (const bf16*)(ws + WS_WT_SGIN) + (size_t)layer * 2 * SGW * D;
                { pg8::Gemm g{P_HB, Wt, T, SGW, D}; pg8::StaticOrder S; S.init(T, SGW, F.G, (int)blockIdx.x); pg8::EpiBf16<1> E{(bf16*)(ws + WS_U), SGW};
                  GEMM_CALL(pg8::EpiBf16<1>, g, S, E); }
                { pg8::Gemm g{Wt + (size_t)SGW * D, P_HB, SGW, T, D}; pg8::StaticOrder S; S.init(SGW, T, F.G, (int)blockIdx.x); pg8::EpiBf16<1> E{(bf16*)(ws + WS_VT), T};
                  GEMM_CALL(pg8::EpiBf16<1>, g, S, E); }
            PH_END
            PH_BEGIN for (int rep_ = 0; rep_ < REP_MISC; ++rep_) colss_phase(F); PH_END
            PH_BEGIN for (int rep_ = 0; rep_ < REP_MISC; ++rep_) spatial_phase(F, layer); PH_END
            PH_BEGIN
                { pg8::Gemm g{(const bf16*)(ws + WS_US), (const bf16*)(ws + WS_WT_SGOUT) + (size_t)layer * D * SGW, T, D, SGW}; pg8::StaticOrder S; S.init(T, D, F.G, (int)blockIdx.x);
                  pg8::EpiResid E{P_XIN, P_XA, D, P_MODS + 2 * D};
                  GEMM_CALL(pg8::EpiResid, g, S, E); }
            PH_END
        } else {
            if (layer == NA) {
                PH_BEGIN
                    { pg8::Gemm g{P_HKV, (const bf16*)(ws + WS_WT_KV), T, NKVC, D}; pg8::StaticOrder S; S.init(T, NKVC, F.G, (int)blockIdx.x); pg8::EpiBf16<0> E{(bf16*)(ws + WS_KV), NKVC};
                      GEMM_CALL(pg8::EpiBf16<0>, g, S, E); }
                PH_END
                PH_BEGIN kvpost_phase(F); PH_END
            }
            PH_BEGIN
                { pg8::Gemm g{P_HB, (const bf16*)(ws + WS_WT_Q) + (size_t)(layer - NA) * D * D, T, D, D}; pg8::StaticOrder S; S.init(T, D, F.G, (int)blockIdx.x); pg8::EpiBf16<0> E{(bf16*)(ws + WS_Q), D};
                  GEMM_CALL(pg8::EpiBf16<0>, g, S, E); }
                for (int rep_ = 0; rep_ < REP_MISC; ++rep_) gates_phase(F, layer - NA);
            PH_END
            PH_BEGIN for (int rep_ = 0; rep_ < REP_ATTN; ++rep_) attn_phase(F, layer - NA); PH_END
            PH_BEGIN
                { pg8::Gemm g{(const bf16*)(ws + WS_ATT), (const bf16*)(ws + WS_WT_O) + (size_t)(layer - NA) * D * D, T, D, D}; pg8::StaticOrder S; S.init(T, D, F.G, (int)blockIdx.x);
                  pg8::EpiResid E{P_XIN, P_XA, D, P_MODS + 2 * D};
                  GEMM_CALL(pg8::EpiResid, g, S, E); }
            PH_END
        }
        PH_BEGIN { const float* mods = P_MODS; rowmod_phase<false>(F, P_XA, P_NG + D, mods + 3 * D, mods + 4 * D, P_HB, nullptr, nullptr, nullptr, nullptr); } PH_END
        PH_BEGIN
            { pg8::Gemm g{P_HB, (const bf16*)(ws + WS_WT_UP) + (size_t)layer * DFF2 * D, T, DFF2, D}; pg8::StaticOrder S; S.init(T, DFF2, F.G, (int)blockIdx.x); pg8::EpiBf16<0> E{(bf16*)(ws + WS_Z), DFF2};
              GEMM_CALL(pg8::EpiBf16<0>, g, S, E); }
        PH_END
        PH_BEGIN for (int rep_ = 0; rep_ < REP_MISC; ++rep_) convgate_phase(F, layer); PH_END
        PH_BEGIN
            { pg8::Gemm g{(const bf16*)(ws + WS_G), (const bf16*)(ws + WS_WT_DOWN) + (size_t)layer * D * DFF, T, D, DFF}; pg8::StaticOrder S; S.init(T, D, F.G, (int)blockIdx.x);
              pg8::EpiResid E{P_XA, P_XOUT, D, P_MODS + 5 * D};
              GEMM_CALL(pg8::EpiResid, g, S, E); }
        PH_END
    }
#undef PH_BEGIN
#undef PH_END
}

extern "C" void kernel_launch(void* const* d_in, const int* in_sizes, int n_in, void* d_out, int out_size, void* d_ws, size_t ws_size, hipStream_t stream) {
    static int grid = 0;
    if (grid == 0) {
        if (n_in != 25 || in_sizes[0] != T * D || out_size != T * D || ws_size < WS_END) { fprintf(stderr, "kernel_launch: unexpected shapes (n_in %d, in0 %d, out %d, ws %zu)\n", n_in, n_in > 0 ? in_sizes[0] : -1, out_size, ws_size); grid = -1; return; }
        int dev = 0, cus = 0, per_cu = 0;
        if (hipGetDevice(&dev) != hipSuccess || hipDeviceGetAttribute(&cus, hipDeviceAttributeMultiprocessorCount, dev) != hipSuccess) { grid = -1; return; }
        if (hipFuncSetAttribute((const void*)yoco_fwd, hipFuncAttributeMaxDynamicSharedMemorySize, LDS_BYTES) != hipSuccess) { fprintf(stderr, "kernel_launch: hipFuncSetAttribute failed\n"); grid = -1; return; }
        if (hipOccupancyMaxActiveBlocksPerMultiprocessor(&per_cu, (const void*)yoco_fwd, NWAVES * 64, LDS_BYTES) != hipSuccess || per_cu < 1)
            fprintf(stderr, "kernel_launch: note: occupancy query reports %d workgroups per CU\n", per_cu);
        (void)hipGetLastError();
        grid = cus;
    }
    if (grid < 0) return;
    if (hipMemsetAsync((char*)d_ws + WS_CTL, 0, CTL_ZERO_BYTES, stream) != hipSuccess) { fprintf(stderr, "kernel_launch: memset failed\n"); return; }
    Args a{};
    for (int i = 0; i < 25; ++i) a.in[i] = (const float*)d_in[i];
    a.out = (float*)d_out; a.ws = (unsigned char*)d_ws;
#if MK_ONE_LAUNCH
    a.ph_lo = 0; a.ph_hi = NPHASES;
    hipLaunchKernelGGL(yoco_fwd, dim3(grid), dim3(NWAVES * 64), LDS_BYTES, stream, a);
#else
    for (int p = 0; p < NPHASES; ++p) { a.ph_lo = p; a.ph_hi = p + 1; hipLaunchKernelGGL(yoco_fwd, dim3(grid), dim3(NWAVES * 64), LDS_BYTES, stream, a); }
#endif
    const hipError_t le = hipPeekAtLastError();
    if (le != hipSuccess) fprintf(stderr, "kernel_launch: launch failed: %s\n", hipGetErrorName(le));
}
```

```cpp
#include <hip/hip_runtime.h>
#include <cstdio>
#include <cstdint>
namespace pg8 {
#define PG8_LAS __attribute__((address_space(3)))
typedef unsigned short bf16_t;
typedef short bf16x8 __attribute__((ext_vector_type(8)));
typedef float f32x4 __attribute__((ext_vector_type(4)));
typedef unsigned u32x4 __attribute__((ext_vector_type(4)));
constexpr int BM = 256, BK = 64, HALF = 128, HTB = HALF * BK * 2  , STAGE_BYTES = 8 * HTB, NXCD = 8, WGM = 8;

__host__ __device__ __forceinline__ int lds_byte(int r, int c) { const int st = (r >> 4) * 2 + (c >> 5), rr = r & 15, cc = c & 31, ob = rr * 64 + cc * 2; return st * 1024 + (ob ^ (((ob >> 9) & 1) << 5)); }
__host__ __device__ __forceinline__ void stage_rc(int b, int& R, int& C) { const int st = b / 1024, sb = b % 1024, swz = sb ^ (((sb >> 9) & 1) << 5); R = (st >> 1) * 16 + swz / 64; C = (st & 1) * 32 + (swz % 64) / 2; }
__host__ __device__ __forceinline__ int perm32(int rho) { const int n = rho >> 4, i = rho & 15; return 8 * (i >> 2) + 4 * n + (i & 3); }

struct Unit { int pm, pn; };
struct Gemm { const bf16_t* A; const bf16_t* Bt; int M, N, K; };

struct StaticOrder {
    int nM, nN, nwg, G, c;
    __host__ __device__ void init(int M, int N, int G_, int c_) { nM = M / BM; nN = N / BM; nwg = nM * nN; G = G_; c = c_; }
    __host__ __device__ bool next(int i, Unit& u) const {
        const long L = (long)i * G + c; if (L >= nwg) return false;
        int wgid = (int)L; { const int q = nwg / NXCD, r = nwg % NXCD, xcd = wgid % NXCD, off = wgid / NXCD; wgid = (xcd < r ? xcd * (q + 1) : r * (q + 1) + (xcd - r) * q) + off; }
        const int nig = WGM * nN, gid = wgid / nig, fm = gid * WGM, gsz = (nM - fm) < WGM ? (nM - fm) : WGM;
        u.pm = fm + ((wgid % nig) % gsz); u.pn = (wgid % nig) / gsz; return true;
    }
    __device__ __forceinline__ void a_ready(const Unit&) const {}
    __device__ __forceinline__ void done(const Unit&) const {}
};


__device__ __forceinline__ unsigned cvt_pk_bf16(float lo, float hi) { unsigned r; asm volatile("v_cvt_pk_bf16_f32 %0, %1, %2" : "=v"(r) : "v"(lo), "v"(hi)); return r; }
__device__ __forceinline__ float gelu_tanh(float v) {
    const float inner = v * (1.0f + 0.044715f * v * v);
    const float e = __builtin_amdgcn_exp2f(-2.3022081997f * inner);
    return v * __builtin_amdgcn_rcpf(1.0f + e);
}
template <int ACT  > struct EpiBf16 {
    static constexpr bool PERM = true, AFTER_DRAIN = false;
    bf16_t* O; int ldc;
    __device__ __forceinline__ void operator()(const f32x4 (&acc)[2][2][4][2], const Unit& u, int wr, int wc, int fr, int fq) const {
        const int row0 = u.pm * BM + wr * 64 + fr; const int col0 = u.pn * BM + wc * 32 + 8 * fq;
#pragma unroll
        for (int ai = 0; ai < 2; ++ai)
#pragma unroll
            for (int m = 0; m < 4; ++m) { bf16_t* rowp = O + (size_t)(row0 + ai * HALF + m * 16) * ldc + col0;
#pragma unroll
                for (int bj = 0; bj < 2; ++bj) { f32x4 v0 = acc[ai][bj][m][0], v1 = acc[ai][bj][m][1];
                    if (ACT == 1) {
#pragma unroll
                        for (int j = 0; j < 4; ++j) { v0[j] = gelu_tanh(v0[j]); v1[j] = gelu_tanh(v1[j]); } }
                    u32x4 w; w.x = cvt_pk_bf16(v0[0], v0[1]); w.y = cvt_pk_bf16(v0[2], v0[3]); w.z = cvt_pk_bf16(v1[0], v1[1]); w.w = cvt_pk_bf16(v1[2], v1[3]);
                    *(u32x4*)(rowp + bj * HALF) = w; } }
    }
};
struct EpiResid {
    static constexpr bool PERM = false, AFTER_DRAIN = false;
    const float* base; float* out; int ldc; const float* gate;
    __device__ __forceinline__ void operator()(const f32x4 (&acc)[2][2][4][2], const Unit& u, int wr, int wc, int fr, int fq) const {
        const int row0 = u.pm * BM + wr * 64 + fr, col0 = u.pn * BM + wc * 32 + 4 * fq;
        f32x4 gv[2][2];
#pragma unroll
        for (int bj = 0; bj < 2; ++bj)
#pragma unroll
            for (int n = 0; n < 2; ++n) gv[bj][n] = *(const f32x4*)(gate + col0 + bj * HALF + n * 16);
#pragma unroll
        for (int ai = 0; ai < 2; ++ai)
#pragma unroll
            for (int m = 0; m < 4; ++m) { const size_t off = (size_t)(row0 + ai * HALF + m * 16) * ldc + col0;
#pragma unroll
                for (int bj = 0; bj < 2; ++bj)
#pragma unroll
                    for (int n = 0; n < 2; ++n) { const f32x4 bs = *(const f32x4*)(base + off + bj * HALF + n * 16);
                        *(f32x4*)(out + off + bj * HALF + n * 16) = bs + gv[bj][n] * acc[ai][bj][m][n]; } }
    }
};
template <class Epi, class Sched, bool ALIGN_EPI = false, bool SP2 = false>
__device__ __forceinline__ void gemm_phase(PG8_LAS unsigned char* lds, const Gemm g, const Sched& S, const Epi& E, const int tid) {
    const int wid = __builtin_amdgcn_readfirstlane(tid >> 6), lane = tid & 63, wr = wid >> 2, wc = wid & 3, fr = lane & 15, fq = lane >> 4;
    const int K = g.K, nt = K / BK;
    unsigned voffA[2], voffB[2];
#pragma unroll
    for (int i = 0; i < 2; ++i) { int R, C; stage_rc(tid * 16 + i * 8192, R, C); const int Rb = Epi::PERM ? ((R & ~31) + perm32(R & 31)) : R;
        voffA[i] = (unsigned)(R * K + C) * 2u; voffB[i] = (unsigned)(Rb * K + C) * 2u; }
    const size_t kstep = (size_t)(BK * 2);
    const size_t hstep = (size_t)HALF * K * 2;
    const size_t tstep = 2 * hstep;
    const unsigned ldsw = (unsigned)wid * 1024u;
    const int aoff = lds_byte(wr * 64 + fr, fq * 8), boff = lds_byte(wc * 32 + fr, fq * 8);
#define PG8_SA(b, h) (((b) * 2 + (h)) * HTB)
#define PG8_SB(b, h) ((4 + (b) * 2 + (h)) * HTB)
#define PG8_STAGE(bufoff, gbase, voff) do { _Pragma("unroll") for (int _i = 0; _i < 2; ++_i) \
        __builtin_amdgcn_global_load_lds((const unsigned*)((const char*)(gbase) + (voff)[_i]), (PG8_LAS unsigned*)(lds + (bufoff) + ldsw + _i * 8192), 16, 0, 0); } while (0)
#define PG8_LDA(dst, b, h) do { _Pragma("unroll") for (int m = 0; m < 4; ++m) _Pragma("unroll") for (int k = 0; k < 2; ++k) dst[m][k] = *(const PG8_LAS bf16x8*)(lds + PG8_SA(b, h) + aoff + m * 2048 + k * 1024); } while (0)
#define PG8_LDB(dst, b, h) do { _Pragma("unroll") for (int n = 0; n < 2; ++n) _Pragma("unroll") for (int k = 0; k < 2; ++k) dst[n][k] = *(const PG8_LAS bf16x8*)(lds + PG8_SB(b, h) + boff + n * 2048 + k * 1024); } while (0)
#define PG8_MMA(ai, bj, At, Bt) do { __builtin_amdgcn_s_setprio(1); _Pragma("unroll") for (int m = 0; m < 4; ++m) _Pragma("unroll") for (int n = 0; n < 2; ++n) _Pragma("unroll") for (int k = 0; k < 2; ++k) \
        acc[ai][bj][m][n] = __builtin_amdgcn_mfma_f32_16x16x32_bf16(Bt[n][k], At[m][k], acc[ai][bj][m][n], 0, 0, 0); __builtin_amdgcn_s_setprio(0); } while (0)
#define PG8_WAIT_V(n) asm volatile("s_waitcnt vmcnt(" #n ")" ::: "memory")
#define PG8_WAIT_L(n) asm volatile("s_waitcnt lgkmcnt(" #n ")" ::: "memory")
#define PG8_BAR __builtin_amdgcn_s_barrier()
#define PG8_SCHED __builtin_amdgcn_sched_barrier(0)
    Unit cur, nxt; int ui = 0;
    if (!S.next(0, cur)) return;
    f32x4 acc[2][2][4][2];
#pragma unroll
    for (int a = 0; a < 2; ++a)
#pragma unroll
        for (int b = 0; b < 2; ++b)
#pragma unroll
            for (int m = 0; m < 4; ++m)
#pragma unroll
                for (int n = 0; n < 2; ++n) acc[a][b][m][n] = (f32x4){0.f, 0.f, 0.f, 0.f};
    bf16x8 At[4][2], B0[2][2], B1[2][2];
    const char* cA = (const char*)g.A + (size_t)cur.pm * tstep; const char* cB = (const char*)g.Bt + (size_t)cur.pn * tstep;
    S.a_ready(cur);
    if constexpr (SP2) {
        PG8_STAGE(PG8_SB(0, 0), cB, voffB); PG8_STAGE(PG8_SB(0, 1), cB + hstep, voffB); PG8_STAGE(PG8_SA(0, 0), cA, voffA); PG8_STAGE(PG8_SA(0, 1), cA + hstep, voffA);
        if (wr == 1) PG8_BAR;
        PG8_WAIT_V(2); PG8_BAR;
        PG8_STAGE(PG8_SB(1, 0), cB + kstep, voffB); PG8_STAGE(PG8_SA(1, 0), cA + kstep, voffA); PG8_STAGE(PG8_SB(1, 1), cB + hstep + kstep, voffB);
        PG8_WAIT_V(6); PG8_BAR;
    } else {
        PG8_STAGE(PG8_SB(0, 0), cB, voffB); PG8_STAGE(PG8_SA(0, 0), cA, voffA); PG8_STAGE(PG8_SB(0, 1), cB + hstep, voffB); PG8_STAGE(PG8_SA(0, 1), cA + hstep, voffA);
        if (wr == 1) PG8_BAR;
        PG8_WAIT_V(4); PG8_BAR;
        PG8_STAGE(PG8_SB(1, 0), cB + kstep, voffB); PG8_STAGE(PG8_SA(1, 0), cA + kstep, voffA); PG8_STAGE(PG8_SB(1, 1), cB + hstep + kstep, voffB);
        PG8_WAIT_V(6); PG8_BAR;
    }
    for (;;) {
        const bool has_next = S.next(ui + 1, nxt);
        const char* nA = has_next ? (const char*)g.A + (size_t)nxt.pm * tstep : cA; const char* nB = has_next ? (const char*)g.Bt + (size_t)nxt.pn * tstep : cB;
        for (int t = 0; t < nt; t += 2) {
            const bool last = (t == nt - 2);
            const char* a1 = cA + (size_t)(t + 1) * kstep;
            const char* a2 = last ? nA : cA + (size_t)(t + 2) * kstep; const char* b2 = last ? nB : cB + (size_t)(t + 2) * kstep;
            const char* a3 = a2 + kstep; const char* b3 = b2 + kstep;
            if (last && has_next) S.a_ready(nxt);
            if constexpr (SP2) {
            PG8_LDB(B0, 0, 0); PG8_LDB(B1, 0, 1); PG8_SCHED; PG8_LDA(At, 0, 0); PG8_STAGE(PG8_SA(1, 1), a1 + hstep, voffA);
            PG8_WAIT_V(8); PG8_WAIT_L(0); PG8_BAR; PG8_MMA(0, 0, At, B0); PG8_MMA(0, 1, At, B1); PG8_BAR; PG8_SCHED;
            PG8_LDA(At, 0, 1); PG8_STAGE(PG8_SB(0, 0), b2, voffB); PG8_STAGE(PG8_SB(0, 1), b2 + hstep, voffB); PG8_STAGE(PG8_SA(0, 0), a2, voffA);
            PG8_WAIT_V(8); PG8_WAIT_L(0); PG8_BAR; PG8_MMA(1, 0, At, B0); PG8_MMA(1, 1, At, B1); PG8_BAR; PG8_SCHED;
            PG8_LDB(B0, 1, 0); PG8_LDB(B1, 1, 1); PG8_SCHED; PG8_LDA(At, 1, 0); PG8_STAGE(PG8_SA(0, 1), a2 + hstep, voffA);
            PG8_WAIT_V(8); PG8_WAIT_L(0); PG8_BAR; PG8_MMA(0, 0, At, B0); PG8_MMA(0, 1, At, B1); PG8_BAR; PG8_SCHED;
            PG8_LDA(At, 1, 1); PG8_STAGE(PG8_SB(1, 0), b3, voffB); PG8_STAGE(PG8_SB(1, 1), b3 + hstep, voffB); PG8_STAGE(PG8_SA(1, 0), a3, voffA);
            PG8_WAIT_V(8); PG8_WAIT_L(0); PG8_BAR; PG8_MMA(1, 0, At, B0); PG8_MMA(1, 1, At, B1); PG8_BAR; PG8_SCHED;
            } else {
            PG8_LDB(B0, 0, 0); PG8_SCHED; PG8_LDA(At, 0, 0); PG8_STAGE(PG8_SA(1, 1), a1 + hstep, voffA);
            PG8_WAIT_L(8); PG8_BAR; PG8_WAIT_L(0); PG8_MMA(0, 0, At, B0); PG8_BAR; PG8_SCHED;
            PG8_LDB(B1, 0, 1); PG8_STAGE(PG8_SB(0, 0), b2, voffB);
            PG8_BAR; PG8_WAIT_L(0); PG8_MMA(0, 1, At, B1); PG8_BAR;
            PG8_LDA(At, 0, 1); PG8_STAGE(PG8_SA(0, 0), a2, voffA);
            PG8_BAR; PG8_WAIT_L(0); PG8_MMA(1, 0, At, B0); PG8_BAR; PG8_SCHED;
            PG8_STAGE(PG8_SB(0, 1), b2 + hstep, voffB);
            PG8_WAIT_V(6); PG8_BAR; PG8_MMA(1, 1, At, B1); PG8_BAR;
            PG8_LDB(B0, 1, 0); PG8_SCHED; PG8_LDA(At, 1, 0); PG8_STAGE(PG8_SA(0, 1), a2 + hstep, voffA);
            PG8_WAIT_L(8); PG8_BAR; PG8_WAIT_L(0); PG8_MMA(0, 0, At, B0); PG8_BAR; PG8_SCHED;
            PG8_LDB(B1, 1, 1); PG8_STAGE(PG8_SB(1, 0), b3, voffB);
            PG8_BAR; PG8_WAIT_L(0); PG8_MMA(0, 1, At, B1); PG8_BAR;
            PG8_LDA(At, 1, 1); PG8_STAGE(PG8_SA(1, 0), a3, voffA);
            PG8_BAR; PG8_WAIT_L(0); PG8_MMA(1, 0, At, B0); PG8_BAR; PG8_SCHED;
            PG8_STAGE(PG8_SB(1, 1), b3 + hstep, voffB);
            PG8_WAIT_V(6); PG8_BAR; PG8_MMA(1, 1, At, B1); PG8_BAR;
            }
        }
        if constexpr (ALIGN_EPI) { if (wr == 0) PG8_BAR; }
        if constexpr (!Epi::AFTER_DRAIN) { E(acc, cur, wr, wc, fr, fq); S.done(cur); }
        if (!has_next) break;
#pragma unroll
        for (int a = 0; a < 2; ++a)
#pragma unroll
            for (int b = 0; b < 2; ++b)
#pragma unroll
                for (int m = 0; m < 4; ++m)
#pragma unroll
                    for (int n = 0; n < 2; ++n) acc[a][b][m][n] = (f32x4){0.f, 0.f, 0.f, 0.f};
        cur = nxt; cA = nA; cB = nB; ++ui;
        if constexpr (ALIGN_EPI) { if (wr == 1) PG8_BAR; }
    }
    PG8_WAIT_V(0);
    if constexpr (!ALIGN_EPI) { if (wr == 0) PG8_BAR; }
    PG8_BAR;
    if constexpr (Epi::AFTER_DRAIN) { E.fused(acc, cur, wr, wc, fr, fq, lds, wid, lane); S.done(cur); }
#undef PG8_SA
#undef PG8_SB
#undef PG8_STAGE
#undef PG8_LDA
#undef PG8_LDB
#undef PG8_MMA
#undef PG8_WAIT_V
#undef PG8_WAIT_L
#undef PG8_BAR
#undef PG8_SCHED
}
}

#ifndef PG8_SP2
#define PG8_SP2 true
#endif
#ifndef PG8_ALIGN
#define PG8_ALIGN true
#endif
#ifndef MK_ONE_LAUNCH
#define MK_ONE_LAUNCH 1
#endif

constexpr int NWAVES = 8;
constexpr int T = 8192, D = 2048, DEPTH = 4, NA = 2;
constexpr int SGW = 4096, SGG = 16, SGD = 256, CHUNK = 128;
constexpr int DFF = 5632, DFF2 = 11264;
constexpr int NH = 16, HD = 128, NKV = 4, NKVC = 3072;
constexpr int NCMP = 511, NSLC = 128, WIN = 512;
constexpr int NQG = 2096;
constexpr int NMOD = 12288;
constexpr float EPS = 1e-6f;
constexpr float NEGBIG = -1e30f;

constexpr size_t MiB = 1u << 20;
constexpr size_t WS_CTL = 0, CTL_ZERO_BYTES = 1 * MiB;
constexpr size_t WS_MODS = 1 * MiB;
constexpr size_t WS_KVMOD = WS_MODS + 4 * NMOD * 4;
constexpr size_t WS_POSB = WS_KVMOD + 4096 * 4;
constexpr size_t WS_WSB = 2 * MiB;
constexpr size_t WS_SSP = 3 * MiB;
constexpr size_t WS_GATES = 4 * MiB;
constexpr size_t WS_KC = 6 * MiB, WS_VC = 7 * MiB;
constexpr size_t WS_W1T = 8 * MiB;
constexpr size_t WS_W2T = 10 * MiB;
constexpr size_t WS_WGT = 11 * MiB;
constexpr size_t WS_WT_SGIN = 16 * MiB;
constexpr size_t WS_WT_SGOUT = 80 * MiB;
constexpr size_t WS_WT_UP = 112 * MiB;
constexpr size_t WS_WT_DOWN = 288 * MiB;
constexpr size_t WS_WT_KV = 376 * MiB;
constexpr size_t WS_WT_Q = 388 * MiB;
constexpr size_t WS_WT_O = 404 * MiB;
constexpr size_t WS_XA = 420 * MiB, WS_XB = 484 * MiB;
constexpr size_t WS_H = 548 * MiB, WS_HKV = 580 * MiB;
constexpr size_t WS_U = 612 * MiB, WS_VT = 676 * MiB, WS_US = 740 * MiB;
constexpr size_t WS_Z = 804 * MiB;
constexpr size_t WS_G = 980 * MiB;
constexpr size_t WS_KV = 1068 * MiB;
constexpr size_t WS_Q = 1116 * MiB, WS_ATT = 1148 * MiB;
constexpr size_t WS_END = 1180 * MiB;
constexpr int CW_BAR = 4096;

constexpr int RING_OFF = 0, RING_BYTES = 131072;
constexpr int LDSCTL_OFF = RING_BYTES, MISC_OFF = LDSCTL_OFF + 320;
constexpr int LDS_BYTES = 147456;
static_assert(MISC_OFF + 128 <= LDS_BYTES, "LDS map");

#define GAS __attribute__((address_space(1)))
#define LAS __attribute__((address_space(3)))
typedef unsigned short bf16;
typedef unsigned v4u __attribute__((ext_vector_type(4)));
typedef unsigned v2u __attribute__((ext_vector_type(2)));
typedef float f32x4 __attribute__((ext_vector_type(4)));
typedef short bf16x8 __attribute__((ext_vector_type(8)));
typedef GAS unsigned gu32;
#define RLX_AGENT __ATOMIC_RELAXED, __HIP_MEMORY_SCOPE_AGENT
#define LDS_WAIT() asm volatile("s_waitcnt lgkmcnt(0)" ::: "memory")
#define VM_WAIT() asm volatile("s_waitcnt vmcnt(0)" ::: "memory")
__device__ __forceinline__ unsigned f2bf(float f) { unsigned u = __builtin_bit_cast(unsigned, f); return (u + 0x7fffu + ((u >> 16) & 1u)) >> 16; }
__device__ __forceinline__ unsigned pk2(float lo, float hi) { return f2bf(lo) | (f2bf(hi) << 16); }
__device__ __forceinline__ float bflo(unsigned w) { return __builtin_bit_cast(float, w << 16); }
__device__ __forceinline__ float bfhi(unsigned w) { return __builtin_bit_cast(float, w & 0xffff0000u); }
__device__ __forceinline__ float bf1(bf16 b) { return __builtin_bit_cast(float, (unsigned)b << 16); }
__device__ __forceinline__ float silu_f(float v) { return v * __builtin_amdgcn_rcpf(1.0f + __builtin_amdgcn_exp2f(-1.4426950409f * v)); }
__device__ __forceinline__ float sigmoid_f(float v) { return __builtin_amdgcn_rcpf(1.0f + __builtin_amdgcn_exp2f(-1.4426950409f * v)); }

#define XB_TMO      128
#define XB_XCNT(j)  (256  + 64 * (j))
#define XB_XSUB(j)  (1280 + 64 * (j))
#define XB_XGEN(j)  (2304 + 64 * (j))
#define XB_TOP      3328
#define XB_TOPGEN   3392
#define XCD_BAR_WORDS 3456
#define XB_SPIN_CAP (1u << 18)

__device__ __forceinline__ unsigned xb_ld(unsigned* p)              { return __hip_atomic_load(p, __ATOMIC_RELAXED, __HIP_MEMORY_SCOPE_AGENT); }
__device__ __forceinline__ unsigned xb_add(unsigned* p, unsigned v) { return __hip_atomic_fetch_add(p, v, __ATOMIC_RELAXED, __HIP_MEMORY_SCOPE_AGENT); }
__device__ __forceinline__ unsigned xb_xcc_id() { return (unsigned)__builtin_amdgcn_s_getreg((3 << 11) | 20) & 0xFu; }
#define XB_SPIN(cond, bar) do { unsigned _sp = 0; while (cond) { __builtin_amdgcn_s_sleep(1); \
    if ((++_sp & 255u) == 0u) { if (xb_ld(&(bar)[XB_TMO])) break; if (_sp > XB_SPIN_CAP) { atomicAdd(&(bar)[XB_TMO], 1u); break; } } } } while (0)

struct XcdBarrier {
    unsigned* bar; unsigned x;
    volatile LAS unsigned* st;
};

__device__ __forceinline__ XcdBarrier xcd_barrier_post(unsigned* bar, volatile LAS unsigned* st) {
    XcdBarrier b; b.bar = bar; b.x = xb_xcc_id(); b.st = st;
    if (threadIdx.x == 0) (void)xb_add(&bar[XB_XCNT(b.x)], 1u);
    return b;
}
__device__ __forceinline__ void xcd_barrier_complete(unsigned* bar, unsigned x, unsigned& nloc, unsigned& nx) {
    const unsigned G = gridDim.x * gridDim.y * gridDim.z;
    unsigned sum, cnt, mine, sp = 0u;
    for (;;) {
        sum = 0u; cnt = 0u; mine = 0u;
#pragma unroll
        for (unsigned j = 0; j < 16; ++j) { const unsigned c = xb_ld(&bar[XB_XCNT(j)]); sum += c; cnt += (c > 0u) ? 1u : 0u; mine = (j == x) ? c : mine; }
        if (sum == G) break;
        __builtin_amdgcn_s_sleep(1);
        if ((++sp & 255u) == 0u) { if (xb_ld(&bar[XB_TMO])) break; if (sp > XB_SPIN_CAP) { atomicAdd(&bar[XB_TMO], 1u); break; } }
    }
    nloc = mine > 0u ? mine : 1u; nx = cnt > 0u ? cnt : 1u;
}

__device__ __forceinline__ void xcd_barrier(const XcdBarrier& b) {
    asm volatile("s_waitcnt vmcnt(0)" ::: "memory");
    __syncthreads();
    if (threadIdx.x == 0) {
        unsigned* bar = b.bar;
        __builtin_amdgcn_s_waitcnt(0);
        unsigned nloc = b.st[0], nx = b.st[1];
        if (nloc == 0u) { xcd_barrier_complete(bar, b.x, nloc, nx); b.st[0] = nloc; b.st[1] = nx; }
        const unsigned old = xb_add(&bar[XB_XSUB(b.x)], 1u);
        const unsigned gen = old / nloc;
        if (old + 1u == (gen + 1u) * nloc) {
            __builtin_amdgcn_fence(__ATOMIC_RELEASE, "agent");
            asm volatile("s_waitcnt vmcnt(0)" ::: "memory");
            const unsigned og = xb_add(&bar[XB_TOP], 1u);
            const unsigned tg = og / nx;
            if (og + 1u == (tg + 1u) * nx) xb_add(&bar[XB_TOPGEN], 1u);
            else XB_SPIN(xb_ld(&bar[XB_TOPGEN]) == tg, bar);
            __builtin_amdgcn_fence(__ATOMIC_ACQUIRE, "agent");
            xb_add(&bar[XB_XGEN(b.x)], 1u);
            asm volatile("s_waitcnt vmcnt(0)" ::: "memory");
        } else {
            XB_SPIN(xb_ld(&bar[XB_XGEN(b.x)]) == gen, bar);
            __builtin_amdgcn_fence(__ATOMIC_ACQUIRE, "agent");
            asm volatile("s_waitcnt vmcnt(0)" ::: "memory");
        }
    }
    __syncthreads();
}

struct Frame {
    LAS unsigned char* lds;
    int tid, lane, wave;
    int vcu, G;
    unsigned char* ws;
};
__device__ __forceinline__ const float* in_ptr(const Frame& F, int i) {
    const volatile LAS unsigned* p = (const volatile LAS unsigned*)(F.lds + LDSCTL_OFF) + 2 * i;
    const unsigned lo = __builtin_amdgcn_readfirstlane(p[0]), hi = __builtin_amdgcn_readfirstlane(p[1]);
    return (const float*)(((unsigned long long)hi << 32) | lo);
}
__device__ __forceinline__ float wave_sum(float v) {
#pragma unroll
    for (int o = 1; o < 64; o <<= 1) v += __shfl_xor(v, o);
    return v;
}
__device__ __forceinline__ float wave_max(float v) {
#pragma unroll
    for (int o = 1; o < 64; o <<= 1) v = fmaxf(v, __shfl_xor(v, o));
    return v;
}

__device__ __forceinline__ void p0_transpose_item(const float* W, int ldw, int K, int N, bf16* WT, LAS float* scr, int item, int lane) {
    const int nblk = N / 32, kb = item / nblk, nb = item % nblk, k0 = 64 * kb, n0 = 32 * nb;
#pragma unroll 8
    for (int i = 0; i < 32; ++i) { const int kk = 2 * i + (lane >> 5); scr[kk * 33 + (lane & 31)] = W[(size_t)(k0 + kk) * ldw + n0 + (lane & 31)]; }
    LDS_WAIT(); asm volatile("" ::: "memory");
    const int c = lane & 7;
#pragma unroll
    for (int j = 0; j < 4; ++j) { const int n = (lane >> 3) + 8 * j; const LAS float* s = scr + (8 * c) * 33 + n;
        v4u o; o.x = pk2(s[0 * 33], s[1 * 33]); o.y = pk2(s[2 * 33], s[3 * 33]); o.z = pk2(s[4 * 33], s[5 * 33]); o.w = pk2(s[6 * 33], s[7 * 33]);
        *(GAS v4u*)(WT + (size_t)(n0 + n) * K + k0 + 8 * c) = o; }
    LDS_WAIT(); asm volatile("" ::: "memory");
}
__device__ __forceinline__ void p0_tr_item(const float* W, int ldw, int K, int N, bf16* WT, LAS unsigned char* tile, int item, int lane) {
    typedef short s16x4_ __attribute__((ext_vector_type(4)));
    const int nblk = N / 64, kb = item / nblk, nb = item - kb * nblk, k0 = 64 * kb, n0 = 64 * nb;
    const int lk = lane >> 4, n4 = (lane & 15) * 4;
    f32x4 v[16];
#pragma unroll
    for (int j = 0; j < 16; ++j) v[j] = *(const GAS f32x4*)(W + (size_t)(k0 + 4 * j + lk) * ldw + n0 + n4);
#pragma unroll
    for (int j = 0; j < 16; ++j) { v2u w; w.x = pk2(v[j].x, v[j].y); w.y = pk2(v[j].z, v[j].w); *(LAS v2u*)(tile + (4 * j + lk) * 136 + n4 * 2) = w; }
    LDS_WAIT(); asm volatile("" ::: "memory");
    const int jg = lane >> 4, i = lane & 15, q = i >> 2, p = i & 3;
    const int tb = (int)(unsigned)(size_t)tile;
#pragma unroll
    for (int r = 0; r < 8; ++r) { const int nb16 = r & 3, kc = 4 * (r >> 2) + jg;
        const int addr = tb + (8 * kc + q) * 136 + (16 * nb16 + 4 * p) * 2;
        s16x4_ lo, hi;
        asm volatile("ds_read_b64_tr_b16 %0, %1" : "=&v"(lo) : "v"(addr) : "memory");
        asm volatile("ds_read_b64_tr_b16 %0, %1 offset:544" : "=&v"(hi) : "v"(addr) : "memory");
        asm volatile("s_waitcnt lgkmcnt(0)" ::: "memory"); __builtin_amdgcn_sched_barrier(0);
        const v2u a = __builtin_bit_cast(v2u, lo), b = __builtin_bit_cast(v2u, hi);
        *(GAS v4u*)(WT + (size_t)(n0 + 16 * nb16 + i) * K + k0 + 8 * kc) = (v4u){a.x, a.y, b.x, b.y}; }
    LDS_WAIT(); asm volatile("" ::: "memory");
}
__device__ __forceinline__ void p0_gemv_item(Frame& F, int it) {
    const float* W; const float* bias; float* out; int N; int col0;
    if (it < 192) { const int l = it / 48, cb = it % 48; W = in_ptr(F, 2) + (size_t)l * D * NMOD; N = NMOD; bias = in_ptr(F, 3) + l * NMOD; out = (float*)(F.ws + WS_MODS) + l * NMOD; col0 = cb * 256; }
    else { const int cb = it - 192; W = in_ptr(F, 15); N = 4096; bias = in_ptr(F, 16); out = (float*)(F.ws + WS_KVMOD); col0 = cb * 256; }
    const float* c = in_ptr(F, 1);
    f32x4 acc = (f32x4){0.f, 0.f, 0.f, 0.f};
    const float* wp = W + (size_t)(F.wave * 256) * N + col0 + 4 * F.lane;
#pragma unroll 8
    for (int k = 0; k < 256; ++k) { const float cv = c[F.wave * 256 + k]; const float s = silu_f(cv); const f32x4 w = *(const GAS f32x4*)(wp + (size_t)k * N); acc += s * w; }
    LAS float* red = (LAS float*)F.lds;
    *(LAS f32x4*)(red + F.wave * 256 + 4 * F.lane) = acc;
    __syncthreads();
    if (F.tid < 256) { float s = bias[col0 + F.tid];
#pragma unroll
        for (int w = 0; w < 8; ++w) s += red[w * 256 + F.tid];
        out[col0 + F.tid] = s; }
    __syncthreads();
}
__device__ __forceinline__ void p0_posb_item(Frame& F, int i) {
    const float* pos = in_ptr(F, 18) + i * 4096; const float* W1 = in_ptr(F, 19) + (size_t)i * 4096 * 128;
    float a0 = 0.f, a1 = 0.f;
    for (int k = F.wave * 512; k < F.wave * 512 + 512; ++k) { const float p = pos[k]; a0 += p * W1[k * 128 + F.lane]; a1 += p * W1[k * 128 + 64 + F.lane]; }
    LAS float* red = (LAS float*)F.lds;
    red[F.wave * 128 + F.lane] = a0; red[F.wave * 128 + 64 + F.lane] = a1;
    __syncthreads();
    if (F.tid < 128) { float s = 0.f;
#pragma unroll
        for (int w = 0; w < 8; ++w) s += red[w * 128 + F.tid];
        ((float*)(F.ws + WS_POSB))[i * 128 + F.tid] = s; }
    __syncthreads();
}
__device__ __forceinline__ void p0_prologue(Frame& F, int rep = 0) {
    for (int it = (int)blockIdx.x; it < 210; it += F.G) { if (it < 208) p0_gemv_item(F, it); else p0_posb_item(F, it - 208); }
    { const float* ws_ = in_ptr(F, 11); bf16* o = (bf16*)(F.ws + WS_WSB);
      for (int i = F.vcu * 512 + F.tid; i < 2 * 16 * 128 * 128; i += F.G * 512) { const int s = i & 127, t = (i >> 7) & 127; o[i] = (s <= t) ? (bf16)f2bf(ws_[i]) : (bf16)0; } }
    { const float* wi = in_ptr(F, 22); bf16* o = (bf16*)(F.ws + WS_WGT);
      for (int i = F.vcu * 512 + F.tid; i < 2 * 48 * D; i += F.G * 512) { const int k = i & (D - 1), c = (i >> 11) % 48, b = i / (48 * D); o[i] = (bf16)f2bf(wi[(size_t)b * D * NQG + (size_t)k * NQG + 2048 + c]); } }
    LAS unsigned char* tile = F.lds + RING_OFF + F.wave * 16384;
    constexpr int I_SGIN = (D / 64) * (2 * SGW / 64), I_SGOUT = (SGW / 64) * (D / 64), I_UP = (D / 64) * (DFF2 / 64), I_DOWN = (DFF / 64) * (D / 64);
    constexpr int I_KV = (D / 64) * (NKVC / 64), I_Q = (D / 64) * (D / 64), I_O = I_Q, I_W1 = (4096 / 64) * (128 / 64), I_W2 = (128 / 64) * (128 / 64);
    constexpr int NITEMS = 2 * I_SGIN + 2 * I_SGOUT + 4 * I_UP + 4 * I_DOWN + I_KV + 2 * I_Q + 2 * I_O + 2 * I_W1 + 2 * I_W2;
    const int gq = (int)(blockIdx.x & 7);
    gu32* qctr = (gu32*)(F.ws + WS_CTL) + 2048 + 64 * gq + 512 * rep;
    int tk = 0; if (F.lane == 0) tk = (int)__hip_atomic_fetch_add(qctr, 1u, RLX_AGENT); tk = __builtin_amdgcn_readfirstlane(tk);
    int sub = 0, nxk = 0;
    for (;;) {
        const int it = (tk * 8 + gq) * 2 + sub;
        if (it >= NITEMS) break;
        int nx = 0; if (sub == 0) { if (F.lane == 0) nx = (int)__hip_atomic_fetch_add(qctr, 1u, RLX_AGENT); }
        int r = it;
        if (r < 2 * I_SGIN) { const int a = r / I_SGIN; r -= a * I_SGIN; p0_tr_item(in_ptr(F, 9) + (size_t)a * D * 2 * SGW, 2 * SGW, D, 2 * SGW, (bf16*)(F.ws + WS_WT_SGIN) + (size_t)a * 2 * SGW * D, tile, r, F.lane); }
        else if ((r -= 2 * I_SGIN) < 2 * I_SGOUT) { const int a = r / I_SGOUT; r -= a * I_SGOUT; p0_tr_item(in_ptr(F, 13) + (size_t)a * SGW * D, D, SGW, D, (bf16*)(F.ws + WS_WT_SGOUT) + (size_t)a * D * SGW, tile, r, F.lane); }
        else if ((r -= 2 * I_SGOUT) < 4 * I_UP) { const int a = r / I_UP; r -= a * I_UP; p0_tr_item(in_ptr(F, 5) + (size_t)a * D * DFF2, DFF2, D, DFF2, (bf16*)(F.ws + WS_WT_UP) + (size_t)a * DFF2 * D, tile, r, F.lane); }
        else if ((r -= 4 * I_UP) < 4 * I_DOWN) { const int a = r / I_DOWN; r -= a * I_DOWN; p0_tr_item(in_ptr(F, 8) + (size_t)a * DFF * D, D, DFF, D, (bf16*)(F.ws + WS_WT_DOWN) + (size_t)a * D * DFF, tile, r, F.lane); }
        else if ((r -= 4 * I_DOWN) < I_KV) { p0_tr_item(in_ptr(F, 17), NKVC, D, NKVC, (bf16*)(F.ws + WS_WT_KV), tile, r, F.lane); }
        else if ((r -= I_KV) < 2 * I_Q) { const int a = r / I_Q; r -= a * I_Q; p0_tr_item(in_ptr(F, 22) + (size_t)a * D * NQG, NQG, D, D, (bf16*)(F.ws + WS_WT_Q) + (size_t)a * D * D, tile, r, F.lane); }
        else if ((r -= 2 * I_Q) < 2 * I_O) { const int a = r / I_O; r -= a * I_O; p0_tr_item(in_ptr(F, 24) + (size_t)a * D * D, D, D, D, (bf16*)(F.ws + WS_WT_O) + (size_t)a * D * D, tile, r, F.lane); }
        else if ((r -= 2 * I_O) < 2 * I_W1) { const int a = r / I_W1; r -= a * I_W1; p0_tr_item(in_ptr(F, 19) + (size_t)a * 4096 * 128, 128, 4096, 128, (bf16*)(F.ws + WS_W1T) + (size_t)a * 128 * 4096, tile, r, F.lane); }
        else { r -= 2 * I_W1; const int a = r / I_W2; r -= a * I_W2; p0_tr_item(in_ptr(F, 20) + (size_t)a * 128 * 128, 128, 128, 128, (bf16*)(F.ws + WS_W2T) + (size_t)a * 128 * 128, tile, r, F.lane); }
        if (sub == 0) { sub = 1; nxk = nx; } else { sub = 0; tk = __builtin_amdgcn_readfirstlane(nxk); }
    }
}

template <bool DUAL>
__device__ __forceinline__ void rowmod_phase(Frame& F, const float* x, const float* gain, const float* shift, const float* scale, bf16* out,
                                             const float* gain2, const float* shift2, const float* scale2, bf16* out2) {
    const int gw = F.vcu * NWAVES + F.wave, NGW = F.G * NWAVES;
    f32x4 ca[8], cb[8], ca2[8], cb2[8];
#pragma unroll
    for (int j = 0; j < 8; ++j) { const int c = 4 * F.lane + 256 * j;
        const f32x4 g = *(const GAS f32x4*)(gain + c), sc = *(const GAS f32x4*)(scale + c); ca[j] = g * (sc + 1.0f); cb[j] = *(const GAS f32x4*)(shift + c);
        if (DUAL) { const f32x4 g2 = *(const GAS f32x4*)(gain2 + c), sc2 = *(const GAS f32x4*)(scale2 + c); ca2[j] = g2 * (sc2 + 1.0f); cb2[j] = *(const GAS f32x4*)(shift2 + c); } }
    for (int m = gw; m < T; m += NGW) {
        const GAS f32x4* xr = (const GAS f32x4*)(x + (size_t)m * D) + F.lane;
        f32x4 v[8]; float s = 0.f;
#pragma unroll
        for (int j = 0; j < 8; ++j) { v[j] = xr[64 * j]; s += (v[j].x * v[j].x + v[j].y * v[j].y) + (v[j].z * v[j].z + v[j].w * v[j].w); }
        const float rstd = 1.0f / sqrtf(wave_sum(s) * (1.0f / D) + EPS);
        GAS v2u* o8 = (GAS v2u*)(out + (size_t)m * D) + F.lane;
#pragma unroll
        for (int j = 0; j < 8; ++j) { const f32x4 y = v[j] * rstd * ca[j] + cb[j]; v2u w; w.x = pk2(y.x, y.y); w.y = pk2(y.z, y.w); o8[64 * j] = w; }
        if (DUAL) { GAS v2u* p8 = (GAS v2u*)(out2 + (size_t)m * D) + F.lane;
#pragma unroll
            for (int j = 0; j < 8; ++j) { const f32x4 y = v[j] * rstd * ca2[j] + cb2[j]; v2u w; w.x = pk2(y.x, y.y); w.y = pk2(y.z, y.w); p8[64 * j] = w; } }
    }
}

__device__ __forceinline__ void colss_phase(Frame& F) {
    const bf16* VT = (const bf16*)(F.ws + WS_VT); float* SSP = (float*)(F.ws + WS_SSP);
    LAS float* red = (LAS float*)F.lds;
    for (int it = F.vcu; it < 512; it += F.G) {
        const int tb = it >> 5, cb = it & 31; const int t0 = tb * 512 + 8 * F.lane;
        float a[8];
#pragma unroll
        for (int e = 0; e < 8; ++e) a[e] = 0.f;
#pragma unroll 4
        for (int i = 0; i < 16; ++i) { const v4u v = *(const GAS v4u*)(VT + (size_t)(cb * 128 + F.wave * 16 + i) * T + t0);
            const unsigned w[4] = {v.x, v.y, v.z, v.w};
#pragma unroll
            for (int q = 0; q < 4; ++q) { const float lo = bflo(w[q]), hi = bfhi(w[q]); a[2 * q] += lo * lo; a[2 * q + 1] += hi * hi; } }
#pragma unroll
        for (int e = 0; e < 8; ++e) red[F.wave * 512 + 8 * F.lane + e] = a[e];
        __syncthreads();
        { float s = 0.f;
#pragma unroll
          for (int w = 0; w < 8; ++w) s += red[w * 512 + F.tid];
          SSP[(size_t)cb * T + tb * 512 + F.tid] = s; }
        __syncthreads();
    }
}
__device__ __forceinline__ void spatial_phase(Frame& F, int a) {
    const bf16* Wc = (const bf16*)(F.ws + WS_WSB) + (size_t)a * 16 * 128 * 128; const float* vgain = in_ptr(F, 10) + a * SGW; const float* bs = in_ptr(F, 12) + a * 16 * 128;
    const bf16* VT = (const bf16*)(F.ws + WS_VT); const bf16* U = (const bf16*)(F.ws + WS_U); bf16* US = (bf16*)(F.ws + WS_US); const float* SSP = (const float*)(F.ws + WS_SSP);
    LAS float* rsl = (LAS float*)F.lds;
    const int wr = F.wave >> 2, wc = F.wave & 3, fr = F.lane & 15, fq = F.lane >> 4;
    for (int unit = F.vcu; unit < 64 * 16; unit += F.G) {
        const int n = unit >> 4, g = unit & 15;
        __syncthreads();
        if (F.tid < 128) { float ss = 0.f;
#pragma unroll 8
            for (int cb = 0; cb < 32; ++cb) ss += SSP[(size_t)cb * T + n * 128 + F.tid];
            rsl[F.tid] = 1.0f / sqrtf(ss * (1.0f / SGW) + EPS); }
        __syncthreads();
        f32x4 acc[4][4];
#pragma unroll
        for (int mi = 0; mi < 4; ++mi)
#pragma unroll
            for (int ni = 0; ni < 4; ++ni) acc[mi][ni] = (f32x4){0.f, 0.f, 0.f, 0.f};
#pragma unroll
        for (int ks = 0; ks < 4; ++ks) {
            if (ks * 32 > wr * 64 + 63) continue;
            float rs[8];
#pragma unroll
            for (int j = 0; j < 8; ++j) rs[j] = rsl[ks * 32 + 8 * fq + j];
            bf16x8 af[4], bfr[4];
#pragma unroll
            for (int mi = 0; mi < 4; ++mi) { const v4u w = *(const GAS v4u*)(Wc + ((size_t)(g * 128 + wr * 64 + mi * 16 + fr) * 128 + ks * 32 + 8 * fq));
                v4u o; o.x = pk2(bflo(w.x) * rs[0], bfhi(w.x) * rs[1]); o.y = pk2(bflo(w.y) * rs[2], bfhi(w.y) * rs[3]); o.z = pk2(bflo(w.z) * rs[4], bfhi(w.z) * rs[5]); o.w = pk2(bflo(w.w) * rs[6], bfhi(w.w) * rs[7]);
                af[mi] = __builtin_bit_cast(bf16x8, o); }
#pragma unroll
            for (int ni = 0; ni < 4; ++ni) bfr[ni] = *(const GAS bf16x8*)(VT + (size_t)(g * 256 + wc * 64 + ni * 16 + fr) * T + n * 128 + ks * 32 + 8 * fq);
#pragma unroll
            for (int mi = 0; mi < 4; ++mi)
#pragma unroll
                for (int ni = 0; ni < 4; ++ni) acc[mi][ni] = __builtin_amdgcn_mfma_f32_16x16x32_bf16(bfr[ni], af[mi], acc[mi][ni], 0, 0, 0);
        }
#pragma unroll
        for (int mi = 0; mi < 4; ++mi) { const int t = wr * 64 + mi * 16 + fr; const float bt = bs[g * 128 + t]; const size_t ro = (size_t)(n * 128 + t) * SGW;
#pragma unroll
            for (int ni = 0; ni < 4; ++ni) { const int cc = g * 256 + wc * 64 + ni * 16 + 4 * fq;
                const v2u uu = *(const GAS v2u*)(U + ro + cc); const f32x4 gv = *(const GAS f32x4*)(vgain + cc); const f32x4 val = acc[mi][ni] * gv + bt;
                v2u o; o.x = pk2(bflo(uu.x) * val.x, bfhi(uu.x) * val.y); o.y = pk2(bflo(uu.y) * val.z, bfhi(uu.y) * val.w);
                *(GAS v2u*)(US + ro + cc) = o; } }
    }
}

__device__ __forceinline__ void unpack8(const v4u p, float (&x)[8]) { x[0] = bflo(p.x); x[1] = bfhi(p.x); x[2] = bflo(p.y); x[3] = bfhi(p.y); x[4] = bflo(p.z); x[5] = bfhi(p.z); x[6] = bflo(p.w); x[7] = bfhi(p.w); }
__device__ __forceinline__ void convgate_phase(Frame& F, int layer) {
    const bf16* Z = (const bf16*)(F.ws + WS_Z); bf16* Gb = (bf16*)(F.ws + WS_G);
    const float* cw = in_ptr(F, 6) + (size_t)layer * 3 * DFF2; const float* cbv = in_ptr(F, 7) + (size_t)layer * DFF2;
    const int gw = F.vcu * NWAVES + F.wave, NGW = F.G * NWAVES;
    const int total = 11 * T, per = (total + NGW - 1) / NGW;
    int L = gw * per; int Lend = L + per; if (Lend > total) Lend = total;
    while (L < Lend) {
        const int cc = L >> 13, tb = L & (T - 1); int n = Lend - L; if (n > T - tb) n = T - tb;
        const int j0 = cc * 512 + 8 * F.lane;
        float wa[3][8], wv[3][8], ba[8], bv[8];
#pragma unroll
        for (int k = 0; k < 3; ++k) { const f32x4 a0 = *(const GAS f32x4*)(cw + k * DFF2 + j0), a1 = *(const GAS f32x4*)(cw + k * DFF2 + j0 + 4), v0 = *(const GAS f32x4*)(cw + k * DFF2 + DFF + j0), v1 = *(const GAS f32x4*)(cw + k * DFF2 + DFF + j0 + 4);
#pragma unroll
            for (int e = 0; e < 4; ++e) { wa[k][e] = a0[e]; wa[k][4 + e] = a1[e]; wv[k][e] = v0[e]; wv[k][4 + e] = v1[e]; } }
        { const f32x4 a0 = *(const GAS f32x4*)(cbv + j0), a1 = *(const GAS f32x4*)(cbv + j0 + 4), v0 = *(const GAS f32x4*)(cbv + DFF + j0), v1 = *(const GAS f32x4*)(cbv + DFF + j0 + 4);
#pragma unroll
          for (int e = 0; e < 4; ++e) { ba[e] = a0[e]; ba[4 + e] = a1[e]; bv[e] = v0[e]; bv[4 + e] = v1[e]; } }
        float a1[8], a2[8], v1[8], v2[8];
#pragma unroll
        for (int e = 0; e < 8; ++e) { a1[e] = 0.f; a2[e] = 0.f; v1[e] = 0.f; v2[e] = 0.f; }
        if (tb >= 1) { unpack8(*(const GAS v4u*)(Z + (size_t)(tb - 1) * DFF2 + j0), a1); unpack8(*(const GAS v4u*)(Z + (size_t)(tb - 1) * DFF2 + DFF + j0), v1); }
        if (tb >= 2) { unpack8(*(const GAS v4u*)(Z + (size_t)(tb - 2) * DFF2 + j0), a2); unpack8(*(const GAS v4u*)(Z + (size_t)(tb - 2) * DFF2 + DFF + j0), v2); }
        int t = tb; const int te = tb + n;
#define CG_ROW(pa, pv, tt) do { float a0[8], v0[8], o[8]; unpack8(pa, a0); unpack8(pv, v0); \
            _Pragma("unroll") for (int e = 0; e < 8; ++e) { const float av = ba[e] + wa[0][e] * a2[e] + wa[1][e] * a1[e] + wa[2][e] * a0[e]; const float vv = bv[e] + wv[0][e] * v2[e] + wv[1][e] * v1[e] + wv[2][e] * v0[e]; \
                o[e] = silu_f(av) * vv; a2[e] = a1[e]; a1[e] = a0[e]; v2[e] = v1[e]; v1[e] = v0[e]; } \
            v4u w; w.x = pk2(o[0], o[1]); w.y = pk2(o[2], o[3]); w.z = pk2(o[4], o[5]); w.w = pk2(o[6], o[7]); *(GAS v4u*)(Gb + (size_t)(tt) * DFF + j0) = w; } while (0)
        for (; t + 4 <= te; t += 4) {
            const bf16* zp = Z + (size_t)t * DFF2 + j0;
            const v4u pa0 = *(const GAS v4u*)(zp), pv0 = *(const GAS v4u*)(zp + DFF), pa1 = *(const GAS v4u*)(zp + DFF2), pv1 = *(const GAS v4u*)(zp + DFF2 + DFF);
            const v4u pa2 = *(const GAS v4u*)(zp + 2 * DFF2), pv2 = *(const GAS v4u*)(zp + 2 * DFF2 + DFF), pa3 = *(const GAS v4u*)(zp + 3 * DFF2), pv3 = *(const GAS v4u*)(zp + 3 * DFF2 + DFF);
            CG_ROW(pa0, pv0, t); CG_ROW(pa1, pv1, t + 1); CG_ROW(pa2, pv2, t + 2); CG_ROW(pa3, pv3, t + 3);
        }
        for (; t < te; ++t) { const bf16* zp = Z + (size_t)t * DFF2 + j0; const v4u pa0 = *(const GAS v4u*)(zp), pv0 = *(const GAS v4u*)(zp + DFF); CG_ROW(pa0, pv0, t); }
#undef CG_ROW
        L += n;
    }
}

constexpr int CP_RED = 0, CP_H1 = 65536, CP_SSP = CP_H1 + 16 * 136 * 2, CP_END = CP_SSP + 8 * 16 * 4;
static_assert(CP_END <= RING_BYTES, "compress LDS");
__device__ __forceinline__ void kvpost_phase(Frame& F) {
    bf16* KV = (bf16*)(F.ws + WS_KV); const float* kg = in_ptr(F, 21);
    const int gw = F.vcu * NWAVES + F.wave, NGW = F.G * NWAVES;
    const int lane = F.lane, fr = lane & 15, fq = lane >> 4, w = F.wave;
    for (int t = gw; t < T; t += NGW) {
#pragma unroll
        for (int q = 0; q < 2; ++q) { const int tensor = q ? 4 : 2; bf16* p = KV + (size_t)t * NKVC + tensor * 512 + 8 * lane;
            const v4u v = *(const GAS v4u*)p; const unsigned wv[4] = {v.x, v.y, v.z, v.w}; float x[8]; float ss = 0.f;
#pragma unroll
            for (int e = 0; e < 4; ++e) { x[2 * e] = bflo(wv[e]); x[2 * e + 1] = bfhi(wv[e]); ss += x[2 * e] * x[2 * e] + x[2 * e + 1] * x[2 * e + 1]; }
            ss += __shfl_xor(ss, 1); ss += __shfl_xor(ss, 2); ss += __shfl_xor(ss, 4); ss += __shfl_xor(ss, 8);
            const float rs = 1.0f / sqrtf(ss * (1.0f / HD) + EPS); const float* gp = kg + (q ? 2 : 1) * HD + ((8 * lane) & 127);
            v4u o; o.x = pk2(x[0] * rs * gp[0], x[1] * rs * gp[1]); o.y = pk2(x[2] * rs * gp[2], x[3] * rs * gp[3]); o.z = pk2(x[4] * rs * gp[4], x[5] * rs * gp[5]); o.w = pk2(x[6] * rs * gp[6], x[7] * rs * gp[7]);
            *(GAS v4u*)p = o; }
    }
    const float* posb = (const float*)(F.ws + WS_POSB);
    LAS f32x4* red = (LAS f32x4*)(F.lds + CP_RED); LAS bf16* h1 = (LAS bf16*)(F.lds + CP_H1); LAS float* ssp = (LAS float*)(F.lds + CP_SSP);
    for (int it = F.vcu; it < 256; it += F.G) {
        const int i = it >> 7, g = (it >> 5) & 3, n0 = (it & 31) * 16;
        const bf16* W1T = (const bf16*)(F.ws + WS_W1T) + (size_t)i * 128 * 4096; const bf16* W2T = (const bf16*)(F.ws + WS_W2T) + (size_t)i * 128 * 128;
        int nrow = n0 + fr; if (nrow > NCMP - 1) nrow = NCMP - 1;
        f32x4 acc[8];
#pragma unroll
        for (int ni = 0; ni < 8; ++ni) acc[ni] = (f32x4){0.f, 0.f, 0.f, 0.f};
#pragma unroll 2
        for (int ks = 0; ks < 16; ++ks) { const int l = 4 * w + (ks >> 2), d0 = (ks & 3) * 32;
            const bf16x8 a = *(const GAS bf16x8*)(KV + (size_t)(16 * nrow + l) * NKVC + i * 512 + g * 128 + d0 + 8 * fq);
            bf16x8 b[8];
#pragma unroll
            for (int ni = 0; ni < 8; ++ni) b[ni] = *(const GAS bf16x8*)(W1T + (size_t)(ni * 16 + fr) * 4096 + (16 * w + ks) * 32 + 8 * fq);
#pragma unroll
            for (int ni = 0; ni < 8; ++ni) acc[ni] = __builtin_amdgcn_mfma_f32_16x16x32_bf16(a, b[ni], acc[ni], 0, 0, 0); }
#pragma unroll
        for (int ni = 0; ni < 8; ++ni) red[(w * 8 + ni) * 64 + lane] = acc[ni];
        __syncthreads();
        { const int e = F.tid, ni = e >> 6, l2 = e & 63; f32x4 v = red[ni * 64 + l2];
#pragma unroll
          for (int ww = 1; ww < 8; ++ww) v += red[(ww * 8 + ni) * 64 + l2];
          const int col = ni * 16 + (l2 & 15); const float pb = posb[i * 128 + col];
#pragma unroll
          for (int q = 0; q < 4; ++q) h1[(4 * (l2 >> 4) + q) * 136 + col] = (bf16)f2bf(pg8::gelu_tanh(v[q] + pb)); }
        __syncthreads();
        f32x4 acc2 = (f32x4){0.f, 0.f, 0.f, 0.f};
#pragma unroll
        for (int k2 = 0; k2 < 4; ++k2) { const bf16x8 a = *(const LAS bf16x8*)(h1 + fr * 136 + k2 * 32 + 8 * fq); const bf16x8 b = *(const GAS bf16x8*)(W2T + (size_t)(16 * w + fr) * 128 + k2 * 32 + 8 * fq);
            acc2 = __builtin_amdgcn_mfma_f32_16x16x32_bf16(a, b, acc2, 0, 0, 0); }
        if (i == 0) {
            float sq[4];
#pragma unroll
            for (int q = 0; q < 4; ++q) { float s = acc2[q] * acc2[q]; s += __shfl_xor(s, 1); s += __shfl_xor(s, 2); s += __shfl_xor(s, 4); s += __shfl_xor(s, 8); sq[q] = s; }
            if (fr == 0) {
#pragma unroll
                for (int q = 0; q < 4; ++q) ssp[w * 16 + 4 * fq + q] = sq[q]; }
            __syncthreads();
#pragma unroll
            for (int q = 0; q < 4; ++q) { float s = 0.f;
#pragma unroll
                for (int ww = 0; ww < 8; ++ww) s += ssp[ww * 16 + 4 * fq + q];
                acc2[q] *= (1.0f / sqrtf(s * (1.0f / HD) + EPS)) * kg[16 * w + fr]; }
        }
        bf16* dst = (bf16*)(F.ws + (i ? WS_VC : WS_KC)) + (size_t)(g * 512) * HD;
#pragma unroll
        for (int q = 0; q < 4; ++q) { const int n = n0 + 4 * fq + q; dst[(size_t)n * HD + 16 * w + fr] = (n < NCMP) ? (bf16)f2bf(acc2[q]) : (bf16)0; }
        __syncthreads();
    }
}

__device__ __forceinline__ void gates_phase(Frame& F, int bl) {
    const bf16* H = (const bf16*)(F.ws + WS_H); float* GT = (float*)(F.ws + WS_GATES); const bf16* WGT = (const bf16*)(F.ws + WS_WGT) + (size_t)bl * 48 * D;
    const int lane = F.lane, fr = lane & 15, fq = lane >> 4, w = F.wave;
    LAS f32x4* red = (LAS f32x4*)(F.lds);
    for (int it = F.vcu; it < T / 32; it += F.G) {
        const int r0 = it * 32;
        f32x4 acc[2][3];
#pragma unroll
        for (int mi = 0; mi < 2; ++mi)
#pragma unroll
            for (int ni = 0; ni < 3; ++ni) acc[mi][ni] = (f32x4){0.f, 0.f, 0.f, 0.f};
#pragma unroll 4
        for (int ks = 0; ks < 8; ++ks) { const int k = 256 * w + ks * 32 + 8 * fq; bf16x8 a[2], b[3];
#pragma unroll
            for (int mi = 0; mi < 2; ++mi) a[mi] = *(const GAS bf16x8*)(H + (size_t)(r0 + mi * 16 + fr) * D + k);
#pragma unroll
            for (int ni = 0; ni < 3; ++ni) b[ni] = *(const GAS bf16x8*)(WGT + (size_t)(ni * 16 + fr) * D + k);
#pragma unroll
            for (int mi = 0; mi < 2; ++mi)
#pragma unroll
                for (int ni = 0; ni < 3; ++ni) acc[mi][ni] = __builtin_amdgcn_mfma_f32_16x16x32_bf16(a[mi], b[ni], acc[mi][ni], 0, 0, 0); }
#pragma unroll
        for (int mi = 0; mi < 2; ++mi)
#pragma unroll
            for (int ni = 0; ni < 3; ++ni) red[((w * 2 + mi) * 3 + ni) * 64 + lane] = acc[mi][ni];
        __syncthreads();
        if (F.tid < 384) { const int e = F.tid, mn = e >> 6, l2 = e & 63, mi = mn / 3, ni = mn - 3 * mi; f32x4 v = red[mn * 64 + l2];
#pragma unroll
            for (int ww = 1; ww < 8; ++ww) v += red[(ww * 6 + mn) * 64 + l2];
#pragma unroll
            for (int q = 0; q < 4; ++q) GT[(size_t)(r0 + mi * 16 + 4 * (l2 >> 4) + q) * 48 + ni * 16 + (l2 & 15)] = sigmoid_f(v[q]); }
        __syncthreads();
    }
}

constexpr int AN_QS = 0, AN_SC = 2048, AN_RI = AN_SC + 8192, AN_IMP = AN_RI + 2048, AN_SEL = AN_IMP + 512, AN_WSL = 13312;
struct AttnState { float m[4], l[4], o[4][2]; };
template <class KeyMap>
__device__ __forceinline__ void attn_chunk(Frame& F, LAS unsigned char* wl, const bf16* Kb, const bf16* Vb, int rstride, int nk, const KeyMap& km, const float (&slope)[4], AttnState& st) {
    LAS float* qs = (LAS float*)(wl + AN_QS); LAS float* sc = (LAS float*)(wl + AN_SC); LAS int* ri = (LAS int*)(wl + AN_RI);
    const int lane = F.lane;
    for (int j = lane; j < nk; j += 64) {
        int row, dist; km(j, row, dist);
        ri[j] = row;
        float a[4] = {0.f, 0.f, 0.f, 0.f};
        if (dist >= 0) {
            const bf16* kp = Kb + (size_t)row * rstride;
#pragma unroll 4
            for (int c = 0; c < 16; ++c) { const v4u v = *(const GAS v4u*)(kp + 8 * c); const unsigned w[4] = {v.x, v.y, v.z, v.w}; float x[8];
#pragma unroll
                for (int e = 0; e < 4; ++e) { x[2 * e] = bflo(w[e]); x[2 * e + 1] = bfhi(w[e]); }
#pragma unroll
                for (int r = 0; r < 4; ++r) { const f32x4 q0 = *(const LAS f32x4*)(qs + r * 128 + 8 * c), q1 = *(const LAS f32x4*)(qs + r * 128 + 8 * c + 4);
                    a[r] += (x[0] * q0.x + x[1] * q0.y) + (x[2] * q0.z + x[3] * q0.w) + (x[4] * q1.x + x[5] * q1.y) + (x[6] * q1.z + x[7] * q1.w); } }
        }
#pragma unroll
        for (int r = 0; r < 4; ++r) sc[r * 512 + j] = dist >= 0 ? a[r] - slope[r] * (float)dist : NEGBIG;
    }
    LDS_WAIT(); asm volatile("" ::: "memory");
#pragma unroll
    for (int r = 0; r < 4; ++r) {
        float cm = NEGBIG;
        for (int j = lane; j < nk; j += 64) cm = fmaxf(cm, sc[r * 512 + j]);
        cm = wave_max(cm);
        const float mn = fmaxf(st.m[r], cm);
        const float alpha = __expf(st.m[r] - mn);
        float ps = 0.f;
        for (int j = lane; j < nk; j += 64) { const float s = sc[r * 512 + j]; const float p = s > -1e29f ? __expf(s - mn) : 0.f; sc[r * 512 + j] = p; ps += p; }
        ps = wave_sum(ps);
        st.l[r] = st.l[r] * alpha + ps; st.o[r][0] *= alpha; st.o[r][1] *= alpha; st.m[r] = mn;
    }
    LDS_WAIT(); asm volatile("" ::: "memory");
    for (int j = 0; j < nk; ++j) {
        const int row = ri[j];
        const unsigned vv = *(const GAS unsigned*)(Vb + (size_t)row * rstride + 2 * lane); const float v0 = bflo(vv), v1 = bfhi(vv);
#pragma unroll
        for (int r = 0; r < 4; ++r) { const float p = sc[r * 512 + j]; st.o[r][0] += p * v0; st.o[r][1] += p * v1; }
    }
    LDS_WAIT(); asm volatile("" ::: "memory");
}
struct KmCmp { int t; __device__ __forceinline__ void operator()(int j, int& row, int& dist) const { row = j; dist = t - (16 * j + 31); } };
struct KmSlc { int t; const LAS int* sel; int base; __device__ __forceinline__ void operator()(int j, int& row, int& dist) const { const int b = sel[base + (j >> 6)]; const int p = 64 * b + (j & 63); row = p; dist = t - p; } };
struct KmWin { int t; int p0; __device__ __forceinline__ void operator()(int j, int& row, int& dist) const { const int p = p0 + j; row = p; dist = t - p; } };

__device__ __forceinline__ void attn_naive_phase(Frame& F, int bl) {
    const bf16* Q = (const bf16*)(F.ws + WS_Q); const bf16* KV = (const bf16*)(F.ws + WS_KV); const bf16* KC = (const bf16*)(F.ws + WS_KC); const bf16* VC = (const bf16*)(F.ws + WS_VC);
    const float* GT = (const float*)(F.ws + WS_GATES); bf16* ATT = (bf16*)(F.ws + WS_ATT); const float* qg = in_ptr(F, 23) + bl * HD;
    const int gw = F.vcu * NWAVES + F.wave, NGW = F.G * NWAVES; const int lane = F.lane;
    LAS unsigned char* wl = F.lds + F.wave * AN_WSL;
    LAS float* qs = (LAS float*)(wl + AN_QS); LAS float* sc = (LAS float*)(wl + AN_SC); LAS float* imp = (LAS float*)(wl + AN_IMP); LAS int* sel = (LAS int*)(wl + AN_SEL);
    const float qscale = 0.08838834764831845f;
    for (int item = gw; item < T * 4; item += NGW) {
        const int t = item >> 2, g = item & 3;
        float slope[4];
#pragma unroll
        for (int r = 0; r < 4; ++r) {
            slope[r] = __builtin_amdgcn_exp2f(-0.5f * (float)(g * 4 + r + 1));
            const unsigned w = *(const GAS unsigned*)(Q + (size_t)t * D + (g * 4 + r) * HD + 2 * lane); const float q0 = bflo(w), q1 = bfhi(w);
            const float ss = wave_sum(q0 * q0 + q1 * q1); const float rs = 1.0f / sqrtf(ss * (1.0f / HD) + EPS) * qscale;
            qs[r * 128 + 2 * lane] = q0 * rs * qg[2 * lane]; qs[r * 128 + 2 * lane + 1] = q1 * rs * qg[2 * lane + 1]; }
        LDS_WAIT(); asm volatile("" ::: "memory");
        float outv[4][2];
        { int nv = t >= 31 ? ((t - 31) >> 4) + 1 : 0; if (nv > NCMP) nv = NCMP;
          AttnState st;
#pragma unroll
          for (int r = 0; r < 4; ++r) { st.m[r] = NEGBIG; st.l[r] = 0.f; st.o[r][0] = 0.f; st.o[r][1] = 0.f; }
          imp[lane] = 0.f; imp[64 + lane] = 0.f;
          if (nv > 0) {
              KmCmp km{t};
              attn_chunk(F, wl, KC + (size_t)g * 512 * HD, VC + (size_t)g * 512 * HD, HD, nv, km, slope, st);
              float inv[4];
#pragma unroll
              for (int r = 0; r < 4; ++r) inv[r] = 1.0f / fmaxf(st.l[r], 1e-30f);
#pragma unroll
              for (int h = 0; h < 2; ++h) { const int s = lane + 64 * h; float a = 0.f;
                  for (int n = 4 * s - 1; n <= 4 * s + 3; ++n) if (n >= 0 && n < nv) { a += sc[n] * inv[0] + sc[512 + n] * inv[1] + sc[1024 + n] * inv[2] + sc[1536 + n] * inv[3]; }
                  imp[s] = a; }
          }
          LDS_WAIT(); asm volatile("" ::: "memory");
#pragma unroll
          for (int r = 0; r < 4; ++r) { const float gt = GT[(size_t)t * 48 + 0 * 16 + g * 4 + r]; const float inv = 1.0f / fmaxf(st.l[r], 1e-30f); outv[r][0] = gt * st.o[r][0] * inv; outv[r][1] = gt * st.o[r][1] * inv; }
        }
        const int cur = t >> 6; int nsel;
        if (cur < 16) { nsel = cur + 1; if (lane < 16) sel[lane] = lane; }
        else {
            nsel = 16;
            float v0 = imp[lane], v1 = imp[64 + lane];
            { const int s0 = lane, s1 = lane + 64; if (s0 < 1 || s0 > cur - 2) v0 = -1.f; if (s1 > cur - 2) v1 = -1.f; }
            if (lane == 0) { sel[0] = 0; sel[1] = cur; sel[2] = cur - 1; }
            for (int k = 0; k < 13; ++k) {
                const float mx = wave_max(fmaxf(v0, v1));
                const unsigned long long b0 = __ballot(v0 == mx), b1 = __ballot(v1 == mx);
                const int idx = b0 ? (int)__builtin_ctzll(b0) : 64 + (int)__builtin_ctzll(b1);
                if (lane == 0) sel[3 + k] = idx;
                if (idx == lane) v0 = -1.f; if (idx == lane + 64) v1 = -1.f;
            }
        }
        LDS_WAIT(); asm volatile("" ::: "memory");
        { AttnState st;
#pragma unroll
          for (int r = 0; r < 4; ++r) { st.m[r] = NEGBIG; st.l[r] = 0.f; st.o[r][0] = 0.f; st.o[r][1] = 0.f; }
          for (int c0 = 0; c0 < nsel; c0 += 8) { const int nb = (nsel - c0) < 8 ? (nsel - c0) : 8; KmSlc km{t, sel, c0};
              attn_chunk(F, wl, KV + 2 * 512 + g * HD, KV + 3 * 512 + g * HD, NKVC, nb * 64, km, slope, st); }
#pragma unroll
          for (int r = 0; r < 4; ++r) { const float gt = GT[(size_t)t * 48 + 1 * 16 + g * 4 + r]; const float inv = 1.0f / fmaxf(st.l[r], 1e-30f); outv[r][0] += gt * st.o[r][0] * inv; outv[r][1] += gt * st.o[r][1] * inv; }
        }
        { AttnState st;
#pragma unroll
          for (int r = 0; r < 4; ++r) { st.m[r] = NEGBIG; st.l[r] = 0.f; st.o[r][0] = 0.f; st.o[r][1] = 0.f; }
          const int p0 = t - (WIN - 1) > 0 ? t - (WIN - 1) : 0; KmWin km{t, p0};
          attn_chunk(F, wl, KV + 4 * 512 + g * HD, KV + 5 * 512 + g * HD, NKVC, t - p0 + 1, km, slope, st);
#pragma unroll
          for (int r = 0; r < 4; ++r) { const float gt = GT[(size_t)t * 48 + 2 * 16 + g * 4 + r]; const float inv = 1.0f / fmaxf(st.l[r], 1e-30f); outv[r][0] += gt * st.o[r][0] * inv; outv[r][1] += gt * st.o[r][1] * inv; }
        }
#pragma unroll
        for (int r = 0; r < 4; ++r) *(GAS unsigned*)(ATT + (size_t)t * D + (g * 4 + r) * HD + 2 * lane) = pk2(outv[r][0], outv[r][1]);
    }
}

namespace att {
typedef short s16x4 __attribute__((ext_vector_type(4)));
typedef float f32x16 __attribute__((ext_vector_type(16)));
typedef unsigned u32x4 __attribute__((ext_vector_type(4)));
constexpr int SHM_K = 16384, SHM_V = 16384;
constexpr int L_K = 0, L_V = 32768, L_IMP = 65536, IMP_STRIDE = 132, L_WS = L_IMP + 8 * 8 * IMP_STRIDE * 4, L_UN = L_WS + 8 * 256, L_END = L_UN + 128;
static_assert(L_END <= RING_BYTES, "attention LDS");
constexpr float THR = 8.0f;
#define KSWZ(row, colB) ((row) * 256 + ((colB) ^ (((row) & 7) << 4)))
#define SBAR() __builtin_amdgcn_sched_barrier(0)
__device__ __forceinline__ int v_st(int k, int c) { const int kk = (k & ~0xC) | ((k & 4) << 1) | ((k & 8) >> 1); return ((kk >> 3) * 4 + (c >> 5)) * 512 + ((kk & 7) * 32 + (c & 31)) * 2; }
__device__ __forceinline__ int v_rd_base(int lane) { return ((lane & 3) << 3) | (((lane >> 2) & 3) << 6) | (((lane >> 4) & 1) << 5) | (((lane >> 5) & 1) << 8); }
constexpr int v_rd_off(int d0, int ks, int half) { return d0 * 512 + ks * 4096 + half * 2048; }
__device__ __forceinline__ int crow(int r, int hi) { return (r & 3) + 8 * (r >> 2) + 4 * hi; }
__device__ __forceinline__ unsigned cvtpk(float lo, float hi) { unsigned r; asm volatile("v_cvt_pk_bf16_f32 %0, %1, %2" : "=v"(r) : "v"(lo), "v"(hi)); return r; }

template <int STRIDE, bool MASKED>
__device__ __forceinline__ void init_p(f32x16& p0, f32x16& p1, float nb, float slope2, int dq, unsigned W) {
    const float NEG = -__builtin_inff();
#pragma unroll
    for (int r = 0; r < 16; ++r) {
        const int c = ((r & 3) + 8 * (r >> 2)) * STRIDE;
        float v0 = fmaf(slope2, (float)c, nb), v1 = fmaf(slope2, (float)(c + 32 * STRIDE), nb);
        if (MASKED) { if ((unsigned)(dq - c) >= W) v0 = NEG; if ((unsigned)(dq - c - 32 * STRIDE) >= W) v1 = NEG; }
        p0[r] = v0; p1[r] = v1;
    }
}
__device__ __forceinline__ void qkt(f32x16& p0, f32x16& p1, const LAS unsigned char* kt, int r32, int hi, const bf16x8 (&qr)[8]) {
    const LAS unsigned char* kb[4];
#pragma unroll
    for (int dd = 0; dd < 4; ++dd) kb[dd] = kt + KSWZ(r32, (dd * 16 + hi * 8) * 2);
#pragma unroll
    for (int d0 = 0; d0 < 8; ++d0) { const LAS unsigned char* a = kb[d0 & 3] + (d0 >> 2) * 128;
        const bf16x8 b0 = *(const LAS bf16x8*)a;
        const bf16x8 b1 = *(const LAS bf16x8*)(a + 32 * 256);
        p0 = __builtin_amdgcn_mfma_f32_32x32x16_bf16(b0, qr[d0], p0, 0, 0, 0);
        p1 = __builtin_amdgcn_mfma_f32_32x32x16_bf16(b1, qr[d0], p1, 0, 0, 0); if (d0 & 1) SBAR(); }
}
__device__ __forceinline__ void pv_tile(f32x16 (&o)[4], int vb, bf16x8 pa0, bf16x8 pa1, bf16x8 pa2, bf16x8 pa3) {
#define TRRD(dst, off) asm volatile("ds_read_b64_tr_b16 %0, %1 offset:%2" : "=&v"(dst) : "v"(vb), "i"(off) : "memory")
#define PV_D0(d0) do { { s16x4 l0, l1, h0, h1; constexpr int b_ = v_rd_off(d0, 0, 0); \
        TRRD(l0, b_); TRRD(h0, b_ + 2048); TRRD(l1, b_ + 4096); TRRD(h1, b_ + 6144); \
        asm volatile("s_waitcnt lgkmcnt(0)" ::: "memory"); SBAR(); \
        o[d0] = __builtin_amdgcn_mfma_f32_32x32x16_bf16(pa0, (bf16x8){l0[0], l0[1], l0[2], l0[3], h0[0], h0[1], h0[2], h0[3]}, o[d0], 0, 0, 0); \
        o[d0] = __builtin_amdgcn_mfma_f32_32x32x16_bf16(pa1, (bf16x8){l1[0], l1[1], l1[2], l1[3], h1[0], h1[1], h1[2], h1[3]}, o[d0], 0, 0, 0); } \
      { s16x4 l2, l3, h2, h3; constexpr int b_ = v_rd_off(d0, 0, 0); \
        TRRD(l2, b_ + 8192); TRRD(h2, b_ + 10240); TRRD(l3, b_ + 12288); TRRD(h3, b_ + 14336); \
        asm volatile("s_waitcnt lgkmcnt(0)" ::: "memory"); SBAR(); \
        o[d0] = __builtin_amdgcn_mfma_f32_32x32x16_bf16(pa2, (bf16x8){l2[0], l2[1], l2[2], l2[3], h2[0], h2[1], h2[2], h2[3]}, o[d0], 0, 0, 0); \
        o[d0] = __builtin_amdgcn_mfma_f32_32x32x16_bf16(pa3, (bf16x8){l3[0], l3[1], l3[2], l3[3], h3[0], h3[1], h3[2], h3[3]}, o[d0], 0, 0, 0); } } while (0)
    PV_D0(0); PV_D0(1); PV_D0(2); PV_D0(3);
#undef PV_D0
#undef TRRD
}
__device__ __forceinline__ float swap_max(float v) { auto rr = __builtin_amdgcn_permlane32_swap(__float_as_uint(v), __float_as_uint(v), false, false); return fmaxf(__uint_as_float(rr[0]), __uint_as_float(rr[1])); }
__device__ __forceinline__ float swap_sum(float v) { auto rr = __builtin_amdgcn_permlane32_swap(__float_as_uint(v), __float_as_uint(v), false, false); return __uint_as_float(rr[0]) + __uint_as_float(rr[1]); }
__device__ __forceinline__ float softmax_tile(f32x16& p0, f32x16& p1, float& m_reg, float& l_reg, bf16x8& pa0, bf16x8& pa1, bf16x8& pa2, bf16x8& pa3) {
    float pmax = p0[0];
#pragma unroll
    for (int r = 1; r < 16; ++r) pmax = fmaxf(pmax, p0[r]);
#pragma unroll
    for (int r = 0; r < 16; ++r) pmax = fmaxf(pmax, p1[r]);
    pmax = swap_max(pmax);
    float mn, alpha;
    if (__all((pmax - m_reg) <= THR)) { mn = m_reg; alpha = 1.f; }
    else { mn = fmaxf(m_reg, pmax); alpha = __builtin_amdgcn_exp2f(m_reg - mn); m_reg = mn; }
#pragma unroll
    for (int r = 0; r < 16; ++r) { p0[r] = __builtin_amdgcn_exp2f(p0[r] - mn); p1[r] = __builtin_amdgcn_exp2f(p1[r] - mn); }
    float ps = 0.f;
#pragma unroll
    for (int r = 0; r < 16; ++r) ps += p0[r] + p1[r];
    ps = swap_sum(ps);
    l_reg = l_reg * alpha + ps;
#define PK4(P, B_, OUT) do { unsigned a0 = cvtpk(P[B_+0], P[B_+1]), a1 = cvtpk(P[B_+2], P[B_+3]); \
        unsigned b0 = cvtpk(P[B_+4], P[B_+5]), b1 = cvtpk(P[B_+6], P[B_+7]); \
        auto r0 = __builtin_amdgcn_permlane32_swap(a0, b0, false, false); auto r1 = __builtin_amdgcn_permlane32_swap(a1, b1, false, false); \
        u32x4 w = {r0[0], r1[0], r0[1], r1[1]}; OUT = __builtin_bit_cast(bf16x8, w); } while (0)
    PK4(p0, 0, pa0); PK4(p0, 8, pa1); PK4(p1, 0, pa2); PK4(p1, 8, pa3);
#undef PK4
    return alpha;
}
__device__ __forceinline__ int next_bit(unsigned long long u0, unsigned long long u1, int from) {
    if (from < 64) { const unsigned long long m = u0 & (~0ull << from); if (m) return (int)__builtin_ctzll(m); from = 64; }
    if (from < 128) { const unsigned long long m = u1 & (~0ull << (from - 64)); if (m) return 64 + (int)__builtin_ctzll(m); }
    return 128;
}
__device__ __forceinline__ bool bit128(unsigned long long u0, unsigned long long u1, int s) { return s < 64 ? ((u0 >> s) & 1ull) != 0 : ((u1 >> (s - 64)) & 1ull) != 0; }
}

__device__ __forceinline__ void attn_unit(Frame& F, int bl, int qb, int g) {
    using namespace att;
    const bf16* Q = (const bf16*)(F.ws + WS_Q); const bf16* KV = (const bf16*)(F.ws + WS_KV); const bf16* KC = (const bf16*)(F.ws + WS_KC) + (size_t)g * 512 * HD; const bf16* VC = (const bf16*)(F.ws + WS_VC) + (size_t)g * 512 * HD;
    const float* GT = (const float*)(F.ws + WS_GATES); bf16* ATT = (bf16*)(F.ws + WS_ATT); const float* qg = in_ptr(F, 23) + bl * HD;
    int tid_ = F.tid; asm volatile("" : "+v"(tid_));
    const int tid = tid_, wid = F.wave, lane = tid & 63, r32 = lane & 31, hi = lane >> 5;
    LAS unsigned char* lds = F.lds;
    const int head = g * 4 + (r32 >> 3), qi = r32 & 7;
    const int t0 = qb * 64, t = t0 + wid * 8 + qi, cur = qb;
    const float slope2 = 1.4426950408889634f * __builtin_amdgcn_exp2f(-0.5f * (float)(head + 1));
    const int sr = tid >> 4, sc = (tid & 15) * 8; const int kws = KSWZ(sr, sc * 2), vst0 = v_st(sr, sc), vst1 = v_st(32 + sr, sc);
    const int vrb = (int)(unsigned)(size_t)(lds + L_V) + v_rd_base(lane);
    LAS float* wsf = (LAS float*)(lds + L_WS + wid * 256);
    LAS float* imp = (LAS float*)(lds + L_IMP) + wid * 8 * IMP_STRIDE;
    bf16x8 qr[8];
    { const bf16* qp = Q + (size_t)t * D + head * HD + hi * 8; float ss = 0.f;
#pragma unroll
      for (int d0 = 0; d0 < 8; ++d0) { qr[d0] = *(const GAS bf16x8*)(qp + d0 * 16); const v4u v = __builtin_bit_cast(v4u, qr[d0]); const unsigned w[4] = {v.x, v.y, v.z, v.w};
#pragma unroll
          for (int e = 0; e < 4; ++e) { const float a_ = bflo(w[e]), b_ = bfhi(w[e]); ss += a_ * a_ + b_ * b_; } }
      ss = swap_sum(ss);
      const float rs = (1.0f / sqrtf(ss * (1.0f / HD) + EPS)) * (0.08838834764831845f * 1.4426950408889634f);
#pragma unroll
      for (int d0 = 0; d0 < 8; ++d0) { const f32x4 g0 = *(const GAS f32x4*)(qg + d0 * 16 + hi * 8), g1 = *(const GAS f32x4*)(qg + d0 * 16 + hi * 8 + 4);
          const v4u v = __builtin_bit_cast(v4u, qr[d0]);
          u32x4 w; w.x = cvtpk(bflo(v.x) * rs * g0.x, bfhi(v.x) * rs * g0.y); w.y = cvtpk(bflo(v.y) * rs * g0.z, bfhi(v.y) * rs * g0.w);
          w.z = cvtpk(bflo(v.z) * rs * g1.x, bfhi(v.z) * rs * g1.y); w.w = cvtpk(bflo(v.w) * rs * g1.z, bfhi(v.w) * rs * g1.w);
          qr[d0] = __builtin_bit_cast(bf16x8, w); if (d0 & 1) SBAR(); } }
    unsigned oacc[4][8];
#pragma unroll
    for (int d0 = 0; d0 < 4; ++d0)
#pragma unroll
        for (int i = 0; i < 8; ++i) oacc[d0][i] = 0u;
    f32x16 o[4]; float m_reg, l_reg;
    bf16x8 st_k0, st_k1, st_v0, st_v1;
#define ST_LOAD(Kp, Vp, rowbase, rstride) do { const size_t o0_ = (size_t)((rowbase) + sr) * (rstride) + sc, o1_ = (size_t)((rowbase) + 32 + sr) * (rstride) + sc; \
        st_k0 = *(const GAS bf16x8*)((Kp) + o0_); st_k1 = *(const GAS bf16x8*)((Kp) + o1_); st_v0 = *(const GAS bf16x8*)((Vp) + o0_); st_v1 = *(const GAS bf16x8*)((Vp) + o1_); } while (0)
#define ST_WRITE(buf) do { *(LAS bf16x8*)(lds + L_K + (buf) * SHM_K + kws) = st_k0; *(LAS bf16x8*)(lds + L_K + (buf) * SHM_K + kws + 32 * 256) = st_k1; \
        *(LAS bf16x8*)(lds + L_V + (buf) * SHM_V + vst0) = st_v0; *(LAS bf16x8*)(lds + L_V + (buf) * SHM_V + vst1) = st_v1; } while (0)
#define BR_RESET() do { m_reg = -1e30f; l_reg = 0.f; _Pragma("unroll") for (int d_ = 0; d_ < 4; ++d_) _Pragma("unroll") for (int r_ = 0; r_ < 16; ++r_) o[d_][r_] = 0.f; } while (0)
#define RESC(a) do { if (__any((a) < 1.f)) { if (hi == 0) wsf[r32] = (a); asm volatile("s_waitcnt lgkmcnt(0)" ::: "memory"); \
        _Pragma("unroll") for (int r_ = 0; r_ < 16; ++r_) { const float al_ = wsf[crow(r_, hi)]; _Pragma("unroll") for (int d_ = 0; d_ < 4; ++d_) o[d_][r_] *= al_; } } } while (0)
#define TILE_COMPUTE(buf, STRIDE, masked, nb, dq, W) do { f32x16 p0, p1; \
        if (masked) init_p<STRIDE, true>(p0, p1, nb, slope2, dq, W); else init_p<STRIDE, false>(p0, p1, nb, slope2, dq, W); \
        qkt(p0, p1, lds + L_K + (buf) * SHM_K, r32, hi, qr); \
        bf16x8 pa0, pa1, pa2, pa3; const float al = softmax_tile(p0, p1, m_reg, l_reg, pa0, pa1, pa2, pa3); RESC(al); \
        pv_tile(o, vrb + (buf) * SHM_V, pa0, pa1, pa2, pa3); } while (0)
#define BR_FOLD(gidx) do { if (hi == 0) wsf[r32] = GT[(size_t)t * 48 + (gidx) * 16 + head] / fmaxf(l_reg, 1e-30f); asm volatile("s_waitcnt lgkmcnt(0)" ::: "memory"); \
        _Pragma("unroll") for (int i_ = 0; i_ < 8; ++i_) { const float f0_ = wsf[crow(2 * i_, hi)], f1_ = wsf[crow(2 * i_ + 1, hi)]; \
            _Pragma("unroll") for (int d_ = 0; d_ < 4; ++d_) { const unsigned w_ = oacc[d_][i_]; oacc[d_][i_] = cvtpk(bflo(w_) + o[d_][2 * i_] * f0_, bfhi(w_) + o[d_][2 * i_ + 1] * f1_); } } } while (0)

    const int NTc = (4 * qb + 3 + 63) >> 6;
    BR_RESET();
    { ST_LOAD(KC, VC, 0, HD); ST_WRITE(0); }
    __syncthreads();
    for (int j = 0; j < NTc; ++j) {
        const int buf = j & 1;
        if (j + 1 < NTc) ST_LOAD(KC, VC, (j + 1) * 64, HD);
        { const int dq = t - (16 * 64 * j + 31) - 64 * hi; const float nb = -slope2 * (float)dq;
          TILE_COMPUTE(buf, 16, true, nb, dq, 0x80000000u); }
        if (j + 1 < NTc) ST_WRITE(buf ^ 1);
        __syncthreads();
    }
    BR_FOLD(0);
    {
#pragma unroll
        for (int i = 0; i < 17; ++i) { const int idx = lane + 64 * i; if (idx < 8 * IMP_STRIDE) imp[idx] = 0.f; }
        const float invl = 1.0f / fmaxf(l_reg, 1e-30f);
        { ST_LOAD(KC, VC, 0, HD); ST_WRITE(0); }
        __syncthreads();
        for (int j = 0; j < NTc; ++j) {
            const int buf = j & 1;
            if (j + 1 < NTc) ST_LOAD(KC, VC, (j + 1) * 64, HD);
            { f32x16 p0, p1; const int dq = t - (16 * 64 * j + 31) - 64 * hi; const float nb = -slope2 * (float)dq;
              init_p<16, true>(p0, p1, nb, slope2, dq, 0x80000000u);
              qkt(p0, p1, lds + L_K + buf * SHM_K, r32, hi, qr);
#pragma unroll
              for (int hf = 0; hf < 2; ++hf)
#pragma unroll
                  for (int a = 0; a < 4; ++a) {
                      float e0, e1, e2, e3;
                      if (hf == 0) { e0 = p0[4 * a]; e1 = p0[4 * a + 1]; e2 = p0[4 * a + 2]; e3 = p0[4 * a + 3]; } else { e0 = p1[4 * a]; e1 = p1[4 * a + 1]; e2 = p1[4 * a + 2]; e3 = p1[4 * a + 3]; }
                      e0 = __builtin_amdgcn_exp2f(e0 - m_reg) * invl; e1 = __builtin_amdgcn_exp2f(e1 - m_reg) * invl; e2 = __builtin_amdgcn_exp2f(e2 - m_reg) * invl; e3 = __builtin_amdgcn_exp2f(e3 - m_reg) * invl;
                      float quad = (e0 + e1) + (e2 + e3), last = e3;
                      quad += __shfl_xor(quad, 8); quad += __shfl_xor(quad, 16); last += __shfl_xor(last, 8); last += __shfl_xor(last, 16);
                      const int s = 16 * j + 8 * hf + 2 * a + hi;
                      if (r32 < 8) { __hip_atomic_fetch_add(imp + qi * IMP_STRIDE + s, quad, __ATOMIC_RELAXED, __HIP_MEMORY_SCOPE_WORKGROUP);
                                     __hip_atomic_fetch_add(imp + qi * IMP_STRIDE + s + 1, last, __ATOMIC_RELAXED, __HIP_MEMORY_SCOPE_WORKGROUP); }
                  }
            }
            if (j + 1 < NTc) ST_WRITE(buf ^ 1);
            __syncthreads();
        }
    }
    unsigned long long wun0 = 0ull, wun1 = 0ull; LAS unsigned* wsel = (LAS unsigned*)(wsf + 32);
    asm volatile("s_waitcnt lgkmcnt(0)" ::: "memory");
    for (int q = 0; q < 8; ++q) {
        unsigned long long b0, b1;
        if (cur < 16) { b0 = (1ull << (cur + 1)) - 1ull; b1 = 0ull; }
        else {
            float v0 = imp[q * IMP_STRIDE + lane], v1 = imp[q * IMP_STRIDE + 64 + lane];
            if (lane < 1 || lane > cur - 2) v0 = -1.f;
            if (lane + 64 > cur - 2) v1 = -1.f;
            bool f0 = false, f1 = false;
            for (int k = 0; k < 13; ++k) {
                const float mx = wave_max(fmaxf(v0, v1));
                const unsigned long long e0 = __ballot(v0 == mx), e1 = __ballot(v1 == mx);
                const int idx = e0 ? (int)__builtin_ctzll(e0) : 64 + (int)__builtin_ctzll(e1);
                if (idx == lane) { v0 = -1.f; f0 = true; }
                if (idx == lane + 64) { v1 = -1.f; f1 = true; }
            }
            b0 = __ballot(f0) | 1ull; b1 = __ballot(f1);
            if (cur < 64) b0 |= 1ull << cur; else b1 |= 1ull << (cur - 64);
            if (cur - 1 < 64) b0 |= 1ull << (cur - 1); else b1 |= 1ull << (cur - 1 - 64);
        }
        if (lane == 0) { wsel[q * 4 + 0] = (unsigned)b0; wsel[q * 4 + 1] = (unsigned)(b0 >> 32); wsel[q * 4 + 2] = (unsigned)b1; wsel[q * 4 + 3] = (unsigned)(b1 >> 32); }
        wun0 |= b0; wun1 |= b1;
    }
    { LAS unsigned long long* un = (LAS unsigned long long*)(lds + L_UN);
      if (lane == 0) { un[wid * 2] = wun0; un[wid * 2 + 1] = wun1; }
      __syncthreads(); }
    unsigned long long u0 = 0ull, u1 = 0ull;
    { const LAS unsigned* un = (const LAS unsigned*)(lds + L_UN);
#pragma unroll
      for (int w = 0; w < 8; ++w) { const unsigned a0 = __builtin_amdgcn_readfirstlane(un[w * 4]), a1 = __builtin_amdgcn_readfirstlane(un[w * 4 + 1]), a2 = __builtin_amdgcn_readfirstlane(un[w * 4 + 2]), a3 = __builtin_amdgcn_readfirstlane(un[w * 4 + 3]);
          u0 |= ((unsigned long long)a1 << 32) | a0; u1 |= ((unsigned long long)a3 << 32) | a2; } }
    { const unsigned x0 = __builtin_amdgcn_readfirstlane((unsigned)wun0), x1 = __builtin_amdgcn_readfirstlane((unsigned)(wun0 >> 32)), x2 = __builtin_amdgcn_readfirstlane((unsigned)wun1), x3 = __builtin_amdgcn_readfirstlane((unsigned)(wun1 >> 32));
      wun0 = ((unsigned long long)x1 << 32) | x0; wun1 = ((unsigned long long)x3 << 32) | x2; }
    {
        const bf16* Kp = KV + 2 * 512 + g * HD; const bf16* Vp = KV + 3 * 512 + g * HD;
        BR_RESET();
        int s = next_bit(u0, u1, 0);
        { ST_LOAD(Kp, Vp, s * 64, NKVC); ST_WRITE(0); }
        __syncthreads();
        int buf = 0;
        while (s < 128) {
            const int sn = next_bit(u0, u1, s + 1);
            if (sn < 128) ST_LOAD(Kp, Vp, sn * 64, NKVC);
            if (bit128(wun0, wun1, s)) {
                const bool rowsel = ((wsel[qi * 4 + (s >> 5)] >> (s & 31)) & 1u) != 0u;
                const int dq = t - 64 * s - 4 * hi; const float nb = rowsel ? -slope2 * (float)dq : -__builtin_inff();
                const bool masked = (s == cur);
                TILE_COMPUTE(buf, 1, masked, nb, dq, 0x80000000u);
            }
            if (sn < 128) ST_WRITE(buf ^ 1);
            __syncthreads();
            buf ^= 1; s = sn;
        }
        BR_FOLD(1);
    }
    {
        const bf16* Kp = KV + 4 * 512 + g * HD; const bf16* Vp = KV + 5 * 512 + g * HD;
        BR_RESET();
        const int s_lo = cur - 8 > 0 ? cur - 8 : 0;
        { ST_LOAD(Kp, Vp, s_lo * 64, NKVC); ST_WRITE(0); }
        __syncthreads();
        int buf = 0;
        for (int s = s_lo; s <= cur; ++s) {
            if (s < cur) ST_LOAD(Kp, Vp, (s + 1) * 64, NKVC);
            { const int dq = t - 64 * s - 4 * hi; const float nb = -slope2 * (float)dq;
              const bool masked = (s == cur) || (s == cur - 8);
              TILE_COMPUTE(buf, 1, masked, nb, dq, (unsigned)WIN); }
            if (s < cur) ST_WRITE(buf ^ 1);
            __syncthreads();
            buf ^= 1;
        }
        BR_FOLD(2);
    }
    {
        LAS bf16* ot = (LAS bf16*)(lds + wid * 8192);
#pragma unroll
        for (int d0 = 0; d0 < 4; ++d0)
#pragma unroll
            for (int i = 0; i < 8; ++i) { const unsigned w = oacc[d0][i]; const int q0 = crow(2 * i, hi);
                ot[q0 * 128 + d0 * 32 + r32] = (bf16)(w & 0xffffu); ot[(q0 + 1) * 128 + d0 * 32 + r32] = (bf16)(w >> 16); }
        asm volatile("s_waitcnt lgkmcnt(0)" ::: "memory");
        int lane2 = lane; asm volatile("" : "+v"(lane2));
#pragma unroll
        for (int i = 0; i < 8; ++i) { const int idx = lane2 + 64 * i; const int q = idx >> 4, ch = idx & 15;
            const v4u v = *(const LAS v4u*)(ot + q * 128 + ch * 8);
            const int tt = t0 + wid * 8 + (q & 7), hh = g * 4 + (q >> 3);
            *(GAS v4u*)(ATT + (size_t)tt * D + hh * HD + ch * 8) = v; }
        __syncthreads();
    }
#undef ST_LOAD
#undef ST_WRITE
#undef BR_RESET
#undef RESC
#undef TILE_COMPUTE
#undef BR_FOLD
}
__device__ __forceinline__ void attn_phase(Frame& F, int bl) {
    for (int u = F.vcu; u < 256; u += F.G) {
        const int g = u & 3, qa = u >> 2;
        for (int h = 0; h < 2; ++h) attn_unit(F, bl, h ? 127 - qa : qa, g);
    }
}

struct Args { const float* in[25]; float* out; unsigned char* ws; int ph_lo, ph_hi; };
constexpr int NPHASES = 37;
__global__ void __launch_bounds__(NWAVES * 64, 2) yoco_fwd(Args args) {
    extern __shared__ __attribute__((aligned(16))) unsigned char lds[];
    Frame F;
    F.lds = (LAS unsigned char*)lds;
    F.tid = threadIdx.x; F.lane = F.tid & 63; F.wave = __builtin_amdgcn_readfirstlane(F.tid >> 6);
    F.G = gridDim.x; { const int bx = blockIdx.x; F.vcu = (F.G % 8 == 0) ? (bx % 8) * (F.G / 8) + bx / 8 : bx; }
    F.ws = args.ws;
    for (int u = F.tid; u < (LDS_BYTES - LDSCTL_OFF) / 4; u += NWAVES * 64) ((LAS unsigned*)(F.lds + LDSCTL_OFF))[u] = 0u;
    __syncthreads();
    if (F.tid < 27) { const unsigned long long pv = F.tid < 25 ? (unsigned long long)args.in[F.tid] : (F.tid == 25 ? (unsigned long long)args.out : (unsigned long long)args.ws);
        volatile LAS unsigned* p = (volatile LAS unsigned*)(F.lds + LDSCTL_OFF) + 2 * F.tid; p[0] = (unsigned)pv; p[1] = (unsigned)(pv >> 32); }
    __syncthreads();
#if MK_ONE_LAUNCH
    constexpr int lo = 0, hi = NPHASES;
#else
    const int lo = args.ph_lo, hi = args.ph_hi;
#endif
    if (hi - lo > 1) { XcdBarrier b0 = xcd_barrier_post((unsigned*)((gu32*)args.ws + CW_BAR), (volatile LAS unsigned*)(F.lds + MISC_OFF) + 8); (void)b0; }
    int pc = 0;
#define PH_BEGIN if (lo <= pc && pc < hi) { unsigned char* ws = (unsigned char*)in_ptr(F, 26); F.ws = ws; \
    { int t_ = threadIdx.x; asm volatile("" : "+v"(t_)); F.tid = t_; F.lane = t_ & 63; F.wave = __builtin_amdgcn_readfirstlane(t_ >> 6); }
#define PH_END } { const bool both_ = (lo <= pc && pc + 1 < hi); ++pc; if (both_) { XcdBarrier bar; bar.bar = (unsigned*)((gu32*)in_ptr(F, 26) + CW_BAR); bar.x = xb_xcc_id(); bar.st = (volatile LAS unsigned*)(F.lds + MISC_OFF) + 8; xcd_barrier(bar); } }
#define P_HB ((bf16*)(ws + WS_H))
#define P_HKV ((bf16*)(ws + WS_HKV))
#define P_XA ((float*)(ws + WS_XA))
#define P_XB ((float*)(ws + WS_XB))
#define P_MODS ((const float*)(ws + WS_MODS) + (size_t)layer * NMOD)
#define P_NG (in_ptr(F, 4) + (size_t)layer * 2 * D)
#define P_XIN (layer == 0 ? in_ptr(F, 0) : (const float*)P_XB)
#define P_XOUT (layer == DEPTH - 1 ? (float*)in_ptr(F, 25) : P_XB)
#define P_RING (F.lds + RING_OFF)
#ifndef REP_P0
#define REP_P0 1
#endif
#ifndef REP_ATTN
#define REP_ATTN 1
#endif
#ifndef REP_GEMM
#define REP_GEMM 1
#endif
#ifndef REP_MISC
#define REP_MISC 1
#endif
#if REP_GEMM == 2
#define GEMM_CALL(EPI, g, S, E) do { pg8::gemm_phase<EPI, pg8::StaticOrder, PG8_ALIGN, PG8_SP2>(P_RING, g, S, E, F.tid); pg8::gemm_phase<EPI, pg8::StaticOrder, PG8_ALIGN, PG8_SP2>(P_RING, g, S, E, F.tid); } while (0)
#else
#define GEMM_CALL(EPI, g, S, E) pg8::gemm_phase<EPI, pg8::StaticOrder, PG8_ALIGN, PG8_SP2>(P_RING, g, S, E, F.tid)
#endif

    PH_BEGIN for (int rep_ = 0; rep_ < REP_P0; ++rep_) { p0_prologue(F, rep_); __syncthreads(); } PH_END

    for (int layer = 0; layer < DEPTH; ++layer) {
        PH_BEGIN
            const float* mods = P_MODS;
            if (layer == NA) { const float* kvm = (const float*)(ws + WS_KVMOD); rowmod_phase<true>(F, P_XIN, P_NG, mods, mods + D, P_HB, in_ptr(F, 14), kvm, kvm + D, P_HKV); }
            else rowmod_phase<false>(F, P_XIN, P_NG, mods, mods + D, P_HB, nullptr, nullptr, nullptr, nullptr);
        PH_END
        if (layer < NA) {
            PH_BEGIN
                const bf16* Wt = (const bf16*)(ws + WS_WT_SGIN) + (size_t)layer * 2 * SGW * D;
                { pg8::Gemm g{P_HB, Wt, T, SGW, D}; pg8::StaticOrder S; S.init(T, SGW, F.G, (int)blockIdx.x); pg8::EpiBf16<1> E{(bf16*)(ws + WS_U), SGW};
                  GEMM_CALL(pg8::EpiBf16<1>, g, S, E); }
                { pg8::Gemm g{Wt + (size_t)SGW * D, P_HB, SGW, T, D}; pg8::StaticOrder S; S.init(SGW, T, F.G, (int)blockIdx.x); pg8::EpiBf16<1> E{(bf16*)(ws + WS_VT), T};
                  GEMM_CALL(pg8::EpiBf16<1>, g, S, E); }
            PH_END
            PH_BEGIN for (int rep_ = 0; rep_ < REP_MISC; ++rep_) colss_phase(F); PH_END
            PH_BEGIN for (int rep_ = 0; rep_ < REP_MISC; ++rep_) spatial_phase(F, layer); PH_END
            PH_BEGIN
                { pg8::Gemm g{(const bf16*)(ws + WS_US), (const bf16*)(ws + WS_WT_SGOUT) + (size_t)layer * D * SGW, T, D, SGW}; pg8::StaticOrder S; S.init(T, D, F.G, (int)blockIdx.x);
                  pg8::EpiResid E{P_XIN, P_XA, D, P_MODS + 2 * D};
                  GEMM_CALL(pg8::EpiResid, g, S, E); }
            PH_END
        } else {
            if (layer == NA) {
                PH_BEGIN
                    { pg8::Gemm g{P_HKV, (const bf16*)(ws + WS_WT_KV), T, NKVC, D}; pg8::StaticOrder S; S.init(T, NKVC, F.G, (int)blockIdx.x); pg8::EpiBf16<0> E{(bf16*)(ws + WS_KV), NKVC};
                      GEMM_CALL(pg8::EpiBf16<0>, g, S, E); }
                PH_END
                PH_BEGIN kvpost_phase(F); PH_END
            }
            PH_BEGIN
                { pg8::Gemm g{P_HB, (const bf16*)(ws + WS_WT_Q) + (size_t)(layer - NA) * D * D, T, D, D}; pg8::StaticOrder S; S.init(T, D, F.G, (int)blockIdx.x); pg8::EpiBf16<0> E{(bf16*)(ws + WS_Q), D};
                  GEMM_CALL(pg8::EpiBf16<0>, g, S, E); }
                for (int rep_ = 0; rep_ < REP_MISC; ++rep_) gates_phase(F, layer - NA);
            PH_END
            PH_BEGIN for (int rep_ = 0; rep_ < REP_ATTN; ++rep_) attn_phase(F, layer - NA); PH_END
            PH_BEGIN
                { pg8::Gemm g{(const bf16*)(ws + WS_ATT), (const bf16*)(ws + WS_WT_O) + (size_t)(layer - NA) * D * D, T, D, D}; pg8::StaticOrder S; S.init(T, D, F.G, (int)blockIdx.x);
                  pg8::EpiResid E{P_XIN, P_XA, D, P_MODS + 2 * D};
                  GEMM_CALL(pg8::EpiResid, g, S, E); }
            PH_END
        }
        PH_BEGIN { const float* mods = P_MODS; rowmod_phase<false>(F, P_XA, P_NG + D, mods + 3 * D, mods + 4 * D, P_HB, nullptr, nullptr, nullptr, nullptr); } PH_END
        PH_BEGIN
            { pg8::Gemm g{P_HB, (const bf16*)(ws + WS_WT_UP) + (size_t)layer * DFF2 * D, T, DFF2, D}; pg8::StaticOrder S; S.init(T, DFF2, F.G, (int)blockIdx.x); pg8::EpiBf16<0> E{(bf16*)(ws + WS_Z), DFF2};
              GEMM_CALL(pg8::EpiBf16<0>, g, S, E); }
        PH_END
        PH_BEGIN for (int rep_ = 0; rep_ < REP_MISC; ++rep_) convgate_phase(F, layer); PH_END
        PH_BEGIN
            { pg8::Gemm g{(const bf16*)(ws + WS_G), (const bf16*)(ws + WS_WT_DOWN) + (size_t)layer * D * DFF, T, D, DFF}; pg8::StaticOrder S; S.init(T, D, F.G, (int)blockIdx.x);
              pg8::EpiResid E{P_XA, P_XOUT, D, P_MODS + 5 * D};
              GEMM_CALL(pg8::EpiResid, g, S, E); }
        PH_END
    }
#undef PH_BEGIN
#undef PH_END
}

extern "C" void kernel_launch(void* const* d_in, const int* in_sizes, int n_in, void* d_out, int out_size, void* d_ws, size_t ws_size, hipStream_t stream) {
    static int grid = 0;
    if (grid == 0) {
        if (n_in != 25 || in_sizes[0] != T * D || out_size != T * D || ws_size < WS_END) { fprintf(stderr, "kernel_launch: unexpected shapes (n_in %d, in0 %d, out %d, ws %zu)\n", n_in, n_in > 0 ? in_sizes[0] : -1, out_size, ws_size); grid = -1; return; }
        int dev = 0, cus = 0, per_cu = 0;
        if (hipGetDevice(&dev) != hipSuccess || hipDeviceGetAttribute(&cus, hipDeviceAttributeMultiprocessorCount, dev) != hipSuccess) { grid = -1; return; }
        if (hipFuncSetAttribute((const void*)yoco_fwd, hipFuncAttributeMaxDynamicSharedMemorySize, LDS_BYTES) != hipSuccess) { fprintf(stderr, "kernel_launch: hipFuncSetAttribute failed\n"); grid = -1; return; }
        if (hipOccupancyMaxActiveBlocksPerMultiprocessor(&per_cu, (const void*)yoco_fwd, NWAVES * 64, LDS_BYTES) != hipSuccess || per_cu < 1)
            fprintf(stderr, "kernel_launch: note: occupancy query reports %d workgroups per CU\n", per_cu);
        (void)hipGetLastError();
        grid = cus;
    }
    if (grid < 0) return;
    if (hipMemsetAsync((char*)d_ws + WS_CTL, 0, CTL_ZERO_BYTES, stream) != hipSuccess) { fprintf(stderr, "kernel_launch: memset failed\n"); return; }
    Args a{};
    for (int i = 0; i < 25; ++i) a.in[i] = (const float*)d_in[i];
    a.out = (float*)d_out; a.ws = (unsigned char*)d_ws;
#if MK_ONE_LAUNCH
    a.ph_lo = 0; a.ph_hi = NPHASES;
    hipLaunchKernelGGL(yoco_fwd, dim3(grid), dim3(NWAVES * 64), LDS_BYTES, stream, a);
#else
    for (int p = 0; p < NPHASES; ++p) { a.ph_lo = p; a.ph_hi = p + 1; hipLaunchKernelGGL(yoco_fwd, dim3(grid), dim3(NWAVES * 64), LDS_BYTES, stream, a); }
#endif
    const hipError_t le = hipPeekAtLastError();
    if (le != hipSuccess) fprintf(stderr, "kernel_launch: launch failed: %s\n", hipGetErrorName(le));
}
```
